# Optimizing an MI355X kernel written in HIP

```python
import math, functools
import jax, jax.numpy as jnp
from jax import lax
import numpy as np

D_MODEL = 1024
BATCH = 16
SEQ = 2048
DEPTH = 4

GRID_W = 64
CTX_LEN = 256
N_EVEN = (DEPTH + 1) // 2
N_ODD = DEPTH // 2
EPS = 1e-6

MLSTM_HEADS = 4
MLSTM_HEAD_DIM = 128
MLSTM_W = MLSTM_HEADS * MLSTM_HEAD_DIM
MLSTM_CHUNK = 64
CONV_W = 3
S5_W = D_MODEL - MLSTM_W
S5_GROUP = 16
S5_GROUPS = S5_W // S5_GROUP
S5_STATE = 64
EV_GATES = 4 * MLSTM_HEADS
P_EVEN = 4 * MLSTM_W + EV_GATES + S5_W
GLA_HEADS = 4
GLA_DK = D_MODEL // 2
GLA_DV = D_MODEL
GLA_RANK = 16
GLA_TAU = 16.0
GLA_CHUNK = 64
P_ODD = 2 * GLA_DK + 2 * GLA_DV + 2 * GLA_RANK
N_EXPERTS = 32
TOP_K = 4
D_EXPERT = D_MODEL
SWIGLU_LIMIT = 7.0
SWIGLU_ALPHA = 1.702
MOE_BLOCK = 128

kernel_name = 'hybrid_mlstm_s5_gla_moe_prefix_dit'


def rmsnorm(x, g):
    xf = x.astype(jnp.float32)
    y = xf * lax.rsqrt(jnp.mean(xf * xf, axis=-1, keepdims=True) + EPS)
    return (y * g.astype(jnp.float32)).astype(x.dtype)


def head_rmsnorm(h, g):
    Bsz, L, H, d = h.shape
    y = h * lax.rsqrt(jnp.mean(h * h, axis=-1, keepdims=True) + EPS)
    return y.reshape(Bsz, L, H * d) * g.astype(jnp.float32)


def modulate(h, shift, scale):
    return h * (1 + scale) + shift


def centred_dwconv(x, w, b):
    L = x.shape[1]
    half = CONV_W // 2
    xp = jnp.pad(x, ((0, 0), (half, half), (0, 0)))
    y = b
    for tap in range(CONV_W):
        y = y + w[tap] * xp[:, tap:tap + L]
    return y


def bidirectional_prefix_scan(run_f, run_b, init, ctx_f, ctx_b, lat_f, lat_b):
    rev = lambda xs: tuple(jnp.flip(a, axis=1) for a in xs)
    yc_f, sc_f = run_f(ctx_f, init)
    yl_f, _ = run_f(lat_f, sc_f)
    yc_b, sc_b = run_b(rev(ctx_b), init)
    yl_b, _ = run_b(rev(lat_b), sc_b)
    return yc_f + jnp.flip(yc_b, axis=1), yl_f + jnp.flip(yl_b, axis=1)


def mlstm_run(inputs, state):
    q, k, v, log_i, log_f = inputs
    Bsz, L, H, dh = q.shape
    T = MLSTM_CHUNK
    nc = L // T
    chunk = lambda a: jnp.moveaxis(a.reshape((Bsz, nc, T) + a.shape[2:]), 1, 0)
    causal = jnp.tril(jnp.ones((T, T), dtype=bool))

    def step(carry, xs):
        C, n, m = carry
        qc, kc, vc, ic, fc = xs
        ic = jnp.swapaxes(ic, 1, 2)
        b = jnp.cumsum(jnp.swapaxes(fc, 1, 2), axis=-1)
        logw = jnp.where(causal, b[..., :, None] - b[..., None, :] + ic[..., None, :], -jnp.inf)
        log_inter = b + m[..., None]
        m_t = jnp.maximum(log_inter, jnp.max(logw, axis=-1))
        w_intra = jnp.exp(logw - m_t[..., None])
        w_inter = jnp.exp(log_inter - m_t)
        scores = jnp.einsum('bthd,bshd->bhts', qc, kc) * w_intra
        num = (jnp.einsum('bhts,bshe->bhte', scores, vc)
               + w_inter[..., None] * jnp.einsum('bthd,bhde->bhte', qc, C))
        den = jnp.sum(scores, axis=-1) + w_inter * jnp.einsum('bthd,bhd->bht', qc, n)
        h = num / jnp.maximum(jnp.abs(den), jnp.exp(-m_t))[..., None]
        b_last = b[..., -1]
        log_g = b_last[..., None] - b + ic
        m_new = jnp.maximum(b_last + m, jnp.max(log_g, axis=-1))
        keep = jnp.exp(b_last + m - m_new)
        w_g = jnp.exp(log_g - m_new[..., None])
        C_new = keep[..., None, None] * C + jnp.einsum('bhs,bshd,bshe->bhde', w_g, kc, vc)
        n_new = keep[..., None] * n + jnp.einsum('bhs,bshd->bhd', w_g, kc)
        return (C_new, n_new, m_new), jnp.swapaxes(h, 1, 2)

    state, hs = lax.scan(step, state, tuple(chunk(a) for a in (q, k, v, log_i, log_f)))
    return jnp.moveaxis(hs, 0, 1).reshape(Bsz, L, H, dh), state


def _complex_affine_combine(e1, e2):
    a1r, a1i, b1r, b1i = e1
    a2r, a2i, b2r, b2i = e2
    return (a2r * a1r - a2i * a1i, a2r * a1i + a2i * a1r,
            a2r * b1r - a2i * b1i + b2r, a2r * b1i + a2i * b1r + b2i)


def s5_run(inputs, state, params):
    (u,) = inputs
    a_re, a_im, log_dt, b_re, b_im, c_re, c_im = (p.astype(jnp.float32) for p in params)
    s0_re, s0_im = state
    L = u.shape[1]
    dt = jnp.exp(log_dt)[:, None]
    lam_re = jnp.minimum(a_re, -1e-4)
    lam_im = a_im
    decay = jnp.exp(lam_re * dt)
    ab_re = decay * jnp.cos(lam_im * dt)
    ab_im = decay * jnp.sin(lam_im * dt)
    den = lam_re * lam_re + lam_im * lam_im
    zr = ((ab_re - 1) * lam_re + ab_im * lam_im) / den
    zi = (ab_im * lam_re - (ab_re - 1) * lam_im) / den
    bb_re = zr[..., None] * b_re - zi[..., None] * b_im
    bb_im = zr[..., None] * b_im + zi[..., None] * b_re
    bu_re = jnp.einsum('blgc,gpc->lbgp', u, bb_re)
    bu_im = jnp.einsum('blgc,gpc->lbgp', u, bb_im)
    a_seq_re = jnp.broadcast_to(ab_re, (L, 1) + ab_re.shape)
    a_seq_im = jnp.broadcast_to(ab_im, (L, 1) + ab_im.shape)
    pw_re, pw_im, s_re, s_im = lax.associative_scan(_complex_affine_combine, (a_seq_re, a_seq_im, bu_re, bu_im))
    s_re, s_im = (s_re + pw_re * s0_re - pw_im * s0_im, s_im + pw_re * s0_im + pw_im * s0_re)
    y = jnp.einsum('lbgp,gcp->blgc', s_re, c_re) - jnp.einsum('lbgp,gcp->blgc', s_im, c_im)
    return y, (s_re[-1], s_im[-1])


def gla_run(inputs, state):
    q, k, v, log_a = inputs
    Bsz, L, H, dk = q.shape
    dv = v.shape[-1]
    T = GLA_CHUNK
    nc = L // T
    chunk = lambda a: jnp.moveaxis(a.reshape((Bsz, nc, T) + a.shape[2:]), 1, 0)
    causal = jnp.tril(jnp.ones((T, T), dtype=bool))[None, :, :, None, None]

    def step(S, xs):
        qc, kc, vc, ac = xs
        b = jnp.cumsum(ac, axis=1)
        rel = jnp.where(causal, b[:, :, None] - b[:, None, :], -jnp.inf)
        att = jnp.einsum('bthd,bshd,btshd->bhts', qc, kc, jnp.exp(rel))
        o = (jnp.einsum('bhts,bshe->bthe', att, vc)
             + jnp.einsum('bthd,bhde->bthe', qc * jnp.exp(b), S))
        b_last = b[:, -1]
        S_new = (jnp.exp(b_last)[..., None] * S
                 + jnp.einsum('bshd,bshe->bhde', kc * jnp.exp(b_last[:, None] - b), vc))
        return S_new, o

    state, os_ = lax.scan(step, state, tuple(chunk(a) for a in (q, k, v, log_a)))
    return jnp.moveaxis(os_, 0, 1).reshape(Bsz, L, H, dv), state


def even_mixer(h_ctx, h_lat, w_in, b_in, conv_w, conv_b, mnorm_g,
               a_re_f, a_im_f, log_dt_f, a_re_b, a_im_b, log_dt_b,
               b_re, b_im, c_re, c_im, d_skip, glu_w, glu_b, w_out):
    H, dh = MLSTM_HEADS, MLSTM_HEAD_DIM
    f32 = jnp.float32

    def prep(h):
        Bsz, L, _ = h.shape
        z = h @ w_in + b_in
        qk, v, o, gates, u = jnp.split(z, [2 * MLSTM_W, 3 * MLSTM_W, 4 * MLSTM_W, 4 * MLSTM_W + EV_GATES], axis=-1)
        qk = jax.nn.silu(centred_dwconv(qk, conv_w, conv_b)).astype(f32)
        q = qk[..., :MLSTM_W].reshape(Bsz, L, H, dh) * dh ** -0.5
        k = qk[..., MLSTM_W:].reshape(Bsz, L, H, dh)
        v = v.astype(f32).reshape(Bsz, L, H, dh)
        gates = gates.astype(f32).reshape(Bsz, L, 4, H)
        fwd = (q, k, v, gates[:, :, 0], jax.nn.log_sigmoid(gates[:, :, 1]))
        bwd = (q, k, v, gates[:, :, 2], jax.nn.log_sigmoid(gates[:, :, 3]))
        return fwd, bwd, o, u.astype(f32).reshape(Bsz, L, S5_GROUPS, S5_GROUP)

    cf, cb, co, cu = prep(h_ctx)
    lf, lb, lo, lu = prep(h_lat)
    Bsz = h_lat.shape[0]
    m_init = (jnp.zeros((Bsz, H, dh, dh), f32), jnp.zeros((Bsz, H, dh), f32), jnp.zeros((Bsz, H), f32))
    mc, ml = bidirectional_prefix_scan(mlstm_run, mlstm_run, m_init, cf, cb, lf, lb)
    s5_f = functools.partial(s5_run, params=(a_re_f, a_im_f, log_dt_f, b_re, b_im, c_re, c_im))
    s5_b = functools.partial(s5_run, params=(a_re_b, a_im_b, log_dt_b, b_re, b_im, c_re, c_im))
    s_init = (jnp.zeros((Bsz, S5_GROUPS, S5_STATE), f32), jnp.zeros((Bsz, S5_GROUPS, S5_STATE), f32))
    sc, sl = bidirectional_prefix_scan(s5_f, s5_b, s_init, (cu,), (cu,), (lu,), (lu,))
    d_grp = d_skip.astype(f32).reshape(S5_GROUPS, S5_GROUP)

    def post(m, o, s, u, dtype):
        Bsz, L = m.shape[:2]
        m_out = head_rmsnorm(m, mnorm_g) * jax.nn.sigmoid(o.astype(f32))
        y = jax.nn.gelu((s + d_grp * u).reshape(Bsz, L, S5_W))
        s_out = y * jax.nn.sigmoid(y @ glu_w.astype(f32) + glu_b.astype(f32))
        return jnp.concatenate([m_out, s_out], axis=-1).astype(dtype) @ w_out

    return post(mc, co, sc, cu, h_ctx.dtype), post(ml, lo, sl, lu, h_lat.dtype)


def odd_mixer(h_ctx, h_lat, w_in, w2_f, b2_f, w2_b, b2_b, norm_g, w_out):
    H = GLA_HEADS
    dk = GLA_DK // H
    dv = GLA_DV // H
    f32 = jnp.float32

    def prep(h):
        Bsz, L, _ = h.shape
        z = h @ w_in
        q, k, v, g, r_f, r_b = jnp.split(
            z, [GLA_DK, 2 * GLA_DK, 2 * GLA_DK + GLA_DV, 2 * GLA_DK + 2 * GLA_DV,
                2 * GLA_DK + 2 * GLA_DV + GLA_RANK], axis=-1)
        heads = lambda a, d: a.astype(f32).reshape(Bsz, L, H, d)
        gate = lambda r, w, b: jax.nn.log_sigmoid((r @ w + b).astype(f32)).reshape(Bsz, L, H, dk) / GLA_TAU
        q = heads(q, dk) * dk ** -0.5
        k = heads(k, dk)
        v = heads(v, dv)
        return (q, k, v, gate(r_f, w2_f, b2_f)), (q, k, v, gate(r_b, w2_b, b2_b)), g

    cf, cb, cg = prep(h_ctx)
    lf, lb, lg = prep(h_lat)
    Bsz = h_lat.shape[0]
    init = jnp.zeros((Bsz, H, dk, dv), f32)
    oc, ol = bidirectional_prefix_scan(gla_run, gla_run, init, cf, cb, lf, lb)

    def post(o, g, dtype):
        y = head_rmsnorm(o, norm_g) * jax.nn.silu(g.astype(f32))
        return y.astype(dtype) @ w_out

    return post(oc, cg, h_ctx.dtype), post(ol, lg, h_lat.dtype)


def moe_ffn(t, router_w, router_b, w_gu, b_gu, w_down, b_down):
    N, D = t.shape
    logits = (t @ router_w + router_b).astype(jnp.float32)
    top_logit, top_e = lax.top_k(logits, TOP_K)
    gate = jax.nn.softmax(top_logit, axis=-1)
    n_assign = N * TOP_K
    flat_e = top_e.reshape(-1)
    order = jnp.argsort(flat_e)
    e_sorted = flat_e[order]
    counts = jnp.bincount(flat_e, length=N_EXPERTS)
    padded = (counts + MOE_BLOCK - 1) // MOE_BLOCK * MOE_BLOCK
    pad_end = jnp.cumsum(padded)
    pad_start = pad_end - padded
    start = jnp.cumsum(counts) - counts
    dest = pad_start[e_sorted] + jnp.arange(n_assign) - start[e_sorted]
    n_blocks = -(-(n_assign + N_EXPERTS * (MOE_BLOCK - 1)) // MOE_BLOCK)
    n_rows = n_blocks * MOE_BLOCK
    row_token = jnp.full((n_rows,), N, jnp.int32).at[dest].set((order // TOP_K).astype(jnp.int32))
    row_gate = jnp.zeros((n_rows,), jnp.float32).at[dest].set(gate.reshape(-1)[order])
    block_expert = jnp.minimum(
        jnp.searchsorted(pad_end, jnp.arange(n_blocks) * MOE_BLOCK, side='right'), N_EXPERTS - 1)
    t_pad = jnp.concatenate([t, jnp.zeros((1, D), t.dtype)], axis=0)
    xb = t_pad[row_token].reshape(n_blocks, MOE_BLOCK, D)

    def expert_block(args):
        xblk, e = args
        gu = xblk @ w_gu[e] + b_gu[e]
        g = jnp.minimum(gu[..., ::2], SWIGLU_LIMIT)
        u = jnp.clip(gu[..., 1::2], -SWIGLU_LIMIT, SWIGLU_LIMIT)
        hdn = (u + 1) * (g * jax.nn.sigmoid(SWIGLU_ALPHA * g))
        return hdn @ w_down[e] + b_down[e]

    yb = lax.map(expert_block, (xb, block_expert)).reshape(n_rows, D)
    out = jnp.zeros((N + 1, D), jnp.float32).at[row_token].add(yb.astype(jnp.float32) * row_gate[:, None])
    return out[:N].astype(t.dtype)


def setup_inputs(seed: int = 0) -> dict:
    key = jax.random.key(seed)
    ks = iter(jax.random.split(key, 64))

    def nrm(shape, scale):
        return jax.random.normal(next(ks), shape, jnp.float32) * scale

    D = D_MODEL
    H = MLSTM_HEADS
    G, P, CG = S5_GROUPS, S5_STATE, S5_GROUP
    forget_offset = jnp.linspace(3.0, 6.0, H)
    gate_offset = jnp.zeros((4, H), jnp.float32).at[1].set(forget_offset).at[3].set(forget_offset).reshape(-1)
    ev_bias_offset = jnp.concatenate([jnp.zeros((4 * MLSTM_W,), jnp.float32), gate_offset,
                                      jnp.zeros((S5_W,), jnp.float32)])
    n_idx = jnp.arange(S5_STATE, dtype=jnp.float32)
    log_dt = lambda: jnp.log(jax.random.uniform(next(ks), (N_EVEN, G), jnp.float32, 1e-3, 1e-1))
    inputs = {
        'x': nrm((BATCH, SEQ, D), 1.0),
        'c': nrm((BATCH, D), 1.0),
        'ctx': nrm((BATCH, CTX_LEN, D), 1.0),
        'c_ctx': nrm((D,), 1.0),
        'mod_w': nrm((DEPTH, D, 6 * D), 0.5 * D ** -0.5),
        'mod_b': nrm((DEPTH, 6 * D), 0.01),
        'norm_mix_g': 1.0 + nrm((DEPTH, D), 0.02),
        'norm_ffn_g': 1.0 + nrm((DEPTH, D), 0.02),
        'ev_w_in': nrm((N_EVEN, D, P_EVEN), D ** -0.5),
        'ev_b_in': nrm((N_EVEN, P_EVEN), 0.01) + ev_bias_offset,
        'ev_conv_w': nrm((N_EVEN, CONV_W, 2 * MLSTM_W), 0.5),
        'ev_conv_b': nrm((N_EVEN, 2 * MLSTM_W), 0.01),
        'ev_mlstm_norm_g': 1.0 + nrm((N_EVEN, MLSTM_W), 0.02),
        'ev_s5_a_re_f': -0.5 + nrm((N_EVEN, G, P), 0.01),
        'ev_s5_a_im_f': math.pi * n_idx + nrm((N_EVEN, G, P), 0.01),
        'ev_s5_log_dt_f': log_dt(),
        'ev_s5_a_re_b': -0.5 + nrm((N_EVEN, G, P), 0.01),
        'ev_s5_a_im_b': math.pi * n_idx + nrm((N_EVEN, G, P), 0.01),
        'ev_s5_log_dt_b': log_dt(),
        'ev_s5_b_re': nrm((N_EVEN, G, P, CG), (2 * CG) ** -0.5),
        'ev_s5_b_im': nrm((N_EVEN, G, P, CG), (2 * CG) ** -0.5),
        'ev_s5_c_re': nrm((N_EVEN, G, CG, P), (2 * P) ** -0.5),
        'ev_s5_c_im': nrm((N_EVEN, G, CG, P), (2 * P) ** -0.5),
        'ev_s5_d': nrm((N_EVEN, S5_W), 1.0),
        'ev_s5_glu_w': nrm((N_EVEN, S5_W, S5_W), S5_W ** -0.5),
        'ev_s5_glu_b': nrm((N_EVEN, S5_W), 0.01),
        'ev_w_out': nrm((N_EVEN, D, D), D ** -0.5),
        'od_w_in': nrm((N_ODD, D, P_ODD), D ** -0.5),
        'od_gate_w2_f': nrm((N_ODD, GLA_RANK, GLA_DK), GLA_RANK ** -0.5),
        'od_gate_b2_f': nrm((N_ODD, GLA_DK), 0.01),
        'od_gate_w2_b': nrm((N_ODD, GLA_RANK, GLA_DK), GLA_RANK ** -0.5),
        'od_gate_b2_b': nrm((N_ODD, GLA_DK), 0.01),
        'od_norm_g': 1.0 + nrm((N_ODD, GLA_DV), 0.02),
        'od_w_out': nrm((N_ODD, GLA_DV, D), GLA_DV ** -0.5),
        'router_w': nrm((DEPTH, D, N_EXPERTS), D ** -0.5),
        'router_b': nrm((DEPTH, N_EXPERTS), 0.01),
        'moe_w_gu': nrm((DEPTH, N_EXPERTS, D, 2 * D_EXPERT), D ** -0.5),
        'moe_b_gu': nrm((DEPTH, N_EXPERTS, 2 * D_EXPERT), 0.01),
        'moe_w_down': nrm((DEPTH, N_EXPERTS, D_EXPERT, D), D_EXPERT ** -0.5),
        'moe_b_down': nrm((DEPTH, N_EXPERTS, D), 0.01),
        'final_norm_g': 1.0 + nrm((D,), 0.02),
    }
    return inputs


def reference(x, c, ctx, c_ctx, mod_w, mod_b, norm_mix_g, norm_ffn_g,
              ev_w_in, ev_b_in, ev_conv_w, ev_conv_b, ev_mlstm_norm_g,
              ev_s5_a_re_f, ev_s5_a_im_f, ev_s5_log_dt_f,
              ev_s5_a_re_b, ev_s5_a_im_b, ev_s5_log_dt_b,
              ev_s5_b_re, ev_s5_b_im, ev_s5_c_re, ev_s5_c_im, ev_s5_d,
              ev_s5_glu_w, ev_s5_glu_b, ev_w_out,
              od_w_in, od_gate_w2_f, od_gate_b2_f, od_gate_w2_b, od_gate_b2_b,
              od_norm_g, od_w_out,
              router_w, router_b, moe_w_gu, moe_b_gu, moe_w_down, moe_b_down,
              final_norm_g):
    Bsz, L, D = x.shape
    rows = L // GRID_W

    def to_cols(a):
        return a.reshape(Bsz, rows, GRID_W, -1).transpose(0, 2, 1, 3).reshape(Bsz, L, -1)

    def to_rows(a):
        return a.reshape(Bsz, GRID_W, rows, -1).transpose(0, 2, 1, 3).reshape(Bsz, L, -1)

    h_lat, h_ctx = x, ctx
    for layer in range(DEPTH):
        last = layer == DEPTH - 1
        j = layer // 2
        mod_lat = (jax.nn.silu(c) @ mod_w[layer] + mod_b[layer])[:, None, :]
        mod_ctx = jax.nn.silu(c_ctx) @ mod_w[layer] + mod_b[layer]
        sh1_l, sc1_l, g1_l, sh2_l, sc2_l, g2_l = jnp.split(mod_lat, 6, axis=-1)
        sh1_c, sc1_c, g1_c, sh2_c, sc2_c, g2_c = jnp.split(mod_ctx, 6, axis=-1)
        a_lat = modulate(rmsnorm(h_lat, norm_mix_g[layer]), sh1_l, sc1_l)
        a_ctx = modulate(rmsnorm(h_ctx, norm_mix_g[layer]), sh1_c, sc1_c)
        if layer % 2 == 0:
            y_ctx, y_lat = even_mixer(
                a_ctx, a_lat, ev_w_in[j], ev_b_in[j], ev_conv_w[j], ev_conv_b[j], ev_mlstm_norm_g[j],
                ev_s5_a_re_f[j], ev_s5_a_im_f[j], ev_s5_log_dt_f[j],
                ev_s5_a_re_b[j], ev_s5_a_im_b[j], ev_s5_log_dt_b[j],
                ev_s5_b_re[j], ev_s5_b_im[j], ev_s5_c_re[j], ev_s5_c_im[j], ev_s5_d[j],
                ev_s5_glu_w[j], ev_s5_glu_b[j], ev_w_out[j])
        else:
            y_ctx, y_lat = odd_mixer(
                a_ctx, to_cols(a_lat), od_w_in[j], od_gate_w2_f[j], od_gate_b2_f[j],
                od_gate_w2_b[j], od_gate_b2_b[j], od_norm_g[j], od_w_out[j])
            y_lat = to_rows(y_lat)
        h_lat = h_lat + g1_l * y_lat
        f_lat = modulate(rmsnorm(h_lat, norm_ffn_g[layer]), sh2_l, sc2_l).reshape(Bsz * L, D)
        moe_params = (router_w[layer], router_b[layer], moe_w_gu[layer], moe_b_gu[layer],
                      moe_w_down[layer], moe_b_down[layer])
        if last:
            h_lat = h_lat + g2_l * moe_ffn(f_lat, *moe_params).reshape(Bsz, L, D)
        else:
            h_ctx = h_ctx + g1_c * y_ctx
            f_ctx = modulate(rmsnorm(h_ctx, norm_ffn_g[layer]), sh2_c, sc2_c).reshape(-1, D)
            n_ctx = f_ctx.shape[0]
            f_all = moe_ffn(jnp.concatenate([f_ctx, f_lat], axis=0), *moe_params)
            h_ctx = h_ctx + g2_c * f_all[:n_ctx].reshape(h_ctx.shape)
            h_lat = h_lat + g2_l * f_all[n_ctx:].reshape(Bsz, L, D)
    return rmsnorm(h_lat, final_norm_g)
```

```cpp
#ifndef HOST_EMU
#include <hip/hip_runtime.h>
#endif
#include <cstdio>
#include <cstdint>

#ifndef CFG_B
#define CFG_B 16
#endif
#ifndef CFG_SEQ
#define CFG_SEQ 2048
#endif
#ifndef CFG_CTX
#define CFG_CTX 256
#endif
#ifndef CFG_DEPTH
#define CFG_DEPTH 4
#endif
#ifndef CFG_NE
#define CFG_NE 32
#endif
#ifndef MULTI_LAUNCH
#define MULTI_LAUNCH 1
#endif

constexpr int D = 1024, BATCH = CFG_B, SEQ = CFG_SEQ, CTXL = CFG_CTX, DEPTH = CFG_DEPTH, NE = CFG_NE, TOPK = 4;
constexpr int N_EVEN = (DEPTH + 1) / 2, N_ODD = DEPTH / 2;
constexpr int NT_CTX = BATCH * CTXL, NT_LAT = BATCH * SEQ, NT = NT_CTX + NT_LAT;
constexpr int GRID_W = 64, GROWS = SEQ / GRID_W;
constexpr int P_EVEN = 2576, P_EVEN_PAD = 2688, P_ODD = 3104, P_ODD_PAD = 3200, ZLD = 3200;
constexpr int NCH_CTX = CTXL / 64, NCH_LAT = SEQ / 64, NCH = NCH_CTX + NCH_LAT;
constexpr int MOE_BM = 256;
constexpr int ROWS_MAX = NT * TOPK + NE * MOE_BM;
constexpr int NTHREADS = 512;
static_assert(NT % 256 == 0, "token count must be a multiple of 256");
static_assert(SEQ % 64 == 0 && CTXL % 64 == 0, "chunking");

typedef unsigned short bf16_t;
#ifndef HOST_EMU
typedef short bf16x8 __attribute__((ext_vector_type(8)));
typedef float f32x4 __attribute__((ext_vector_type(4)));
typedef float f32x16 __attribute__((ext_vector_type(16)));
#endif
typedef unsigned u32x4 __attribute__((ext_vector_type(4)));
typedef unsigned u32x2 __attribute__((ext_vector_type(2)));

#ifdef HOST_EMU
#define MFMA16(a, b, c) emu_mfma_16x16x32_bf16(a, b, c)
#define MFMA32(a, b, c) emu_mfma_32x32x16_bf16(a, b, c)
#define GLDS16(g, l) emu_glds16((const void*)(g), (void*)(l))
#define WAIT_VM0() do {} while (0)
#define SMEM_DECL char* smem = emu::g_smem
#define LAUNCH(kern, grid, block, lds, stream, ...) emu::launch(grid, block, lds, [=]() { kern(__VA_ARGS__); })
#else
#define LDSAS __attribute__((address_space(3)))
#define MFMA16(a, b, c) __builtin_amdgcn_mfma_f32_16x16x32_bf16(a, b, c, 0, 0, 0)
#define MFMA32(a, b, c) __builtin_amdgcn_mfma_f32_32x32x16_bf16(a, b, c, 0, 0, 0)
#define GLDS16(g, l) __builtin_amdgcn_global_load_lds((const unsigned*)(g), (LDSAS unsigned*)(l), 16, 0, 0)
#define WAIT_VM0() asm volatile("s_waitcnt vmcnt(0)" ::: "memory")
#define SMEM_DECL extern __shared__ __attribute__((aligned(256))) char smem[]
#define LAUNCH(kern, grid, block, lds, stream, ...) hipLaunchKernelGGL(kern, dim3(grid), dim3(block), lds, stream, __VA_ARGS__)
#endif

__device__ __forceinline__ float bf2f(bf16_t v) { unsigned u = ((unsigned)v) << 16; return __builtin_bit_cast(float, u); }
__device__ __forceinline__ bf16_t f2bf(float f) { unsigned u = __builtin_bit_cast(unsigned, f); u += 0x7fffu + ((u >> 16) & 1u); return (bf16_t)(u >> 16); }
__device__ __forceinline__ unsigned pack2bf(float lo, float hi) { return (unsigned)f2bf(lo) | ((unsigned)f2bf(hi) << 16); }
__device__ __forceinline__ float sigmoidf_(float x) { return 1.f / (1.f + __expf(-x)); }
__device__ __forceinline__ float siluf_(float x) { return x / (1.f + __expf(-x)); }
__device__ __forceinline__ float logsigmoidf_(float x) { return fminf(x, 0.f) - log1pf(__expf(-fabsf(x))); }
__device__ __forceinline__ float gelu_tanhf_(float x) { float u = 0.7978845608028654f * (x + 0.044715f * x * x * x); float t = 1.f - 2.f / (1.f + __expf(2.f * u)); return 0.5f * x * (1.f + t); }
__device__ __forceinline__ float wave_sum(float v) { for (int m = 32; m >= 1; m >>= 1) v += __shfl_xor(v, m); return v; }
__device__ __forceinline__ float group16_sum(float v) { for (int m = 8; m >= 1; m >>= 1) v += __shfl_xor(v, m); return v; }

enum { I_X = 0, I_C, I_CTX, I_CCTX, I_MODW, I_MODB, I_NMIXG, I_NFFNG, I_EVWIN, I_EVBIN, I_EVCONVW, I_EVCONVB, I_EVMNORM,
       I_AREF, I_AIMF, I_LDTF, I_AREB, I_AIMB, I_LDTB, I_S5BRE, I_S5BIM, I_S5CRE, I_S5CIM, I_S5D, I_GLUW, I_GLUB, I_EVWOUT,
       I_ODWIN, I_ODW2F, I_ODB2F, I_ODW2B, I_ODB2B, I_ODNORM, I_ODWOUT, I_RW, I_RB, I_WGU, I_BGU, I_WDN, I_BDN, I_FNORM, N_INPUTS };

struct Params { const float* in[N_INPUTS]; float* out; char* ws; };

constexpr size_t al256(size_t x) { return (x + 255) & ~(size_t)255; }
constexpr int XCD_BAR_WORDS_C = 3456;
constexpr size_t WS_BAR = 0;
constexpr size_t WS_CNT = WS_BAR + (size_t)XCD_BAR_WORDS_C * 4;
constexpr size_t WS_ZERO_BYTES = al256(WS_CNT + (size_t)DEPTH * NE * 4);
constexpr size_t WS_MODV = WS_ZERO_BYTES;
constexpr size_t WS_H = al256(WS_MODV + (size_t)DEPTH * (BATCH + 1) * 6 * D * 4);
constexpr size_t WS_A = al256(WS_H + (size_t)NT * D * 4);
constexpr size_t WS_CAT = al256(WS_A + (size_t)NT * D * 2);
constexpr size_t WS_Z = al256(WS_CAT + (size_t)NT * D * 2);
constexpr size_t WS_GATES = al256(WS_Z + (size_t)NT * ZLD * 2);
constexpr size_t WS_QK = al256(WS_GATES + (size_t)NT * 32 * 4);
constexpr size_t WS_MO = al256(WS_QK + (size_t)NT * D * 2);
constexpr size_t WS_YY = al256(WS_MO + (size_t)2 * NT * D * 4);
constexpr size_t WS_TOKE = al256(WS_YY + (size_t)NT * 512 * 2);
constexpr size_t WS_TOKPOS = al256(WS_TOKE + (size_t)NT * 4 * 4);
constexpr size_t WS_TOKGATE = al256(WS_TOKPOS + (size_t)NT * 4 * 4);
constexpr size_t WS_ROWTOK = al256(WS_TOKGATE + (size_t)NT * 4 * 4);
constexpr size_t WS_HDN = al256(WS_ROWTOK + (size_t)NE * NT * 4);
constexpr size_t WS_YB = al256(WS_HDN + (size_t)ROWS_MAX * D * 2);
constexpr size_t WS_WEVIN = al256(WS_YB + (size_t)ROWS_MAX * D * 2);
constexpr size_t WS_WODIN = al256(WS_WEVIN + (size_t)N_EVEN * P_EVEN_PAD * D * 2);
constexpr size_t WS_WEVOUT = al256(WS_WODIN + (size_t)N_ODD * P_ODD_PAD * D * 2);
constexpr size_t WS_WGLU = al256(WS_WEVOUT + (size_t)N_EVEN * D * D * 2);
constexpr size_t WS_WODOUT = al256(WS_WGLU + (size_t)N_EVEN * 512 * 512 * 2);
constexpr size_t WS_WGU = al256(WS_WODOUT + (size_t)N_ODD * D * D * 2);
constexpr size_t WS_WDN = al256(WS_WGU + (size_t)DEPTH * NE * 2 * D * D * 2);
constexpr size_t WS_TOTAL = al256(WS_WDN + (size_t)DEPTH * NE * D * D * 2);

__device__ __forceinline__ int mod_row(int r) { return r < NT_CTX ? BATCH : (r - NT_CTX) / SEQ; }
__device__ __forceinline__ const float* modv(const Params& P, int layer, int r, int part) { return (const float*)(P.ws + WS_MODV) + ((size_t)(layer * (BATCH + 1) + mod_row(r)) * 6 + part) * D; }

constexpr int GEMM_LDS = 2 * 32768 + 2 * 16384;
template <class ARow, class Epi>
__device__ __forceinline__ void gemm_tile(char* smem, ARow arow, const bf16_t* Bt, int ldb, int K, Epi epi) {
    const int tid = threadIdx.x, wid = tid >> 6, lane = tid & 63, wr = wid >> 1, wc = wid & 1, fr = lane & 15, fq = lane >> 4;
    const char* ap[4]; const char* bp[2];
#pragma unroll
    for (int i = 0; i < 4; ++i) { const int id = tid + i * 512, row = id >> 3, c = (id & 7) ^ (row & 7); ap[i] = (const char*)arow(row) + c * 16; }
#pragma unroll
    for (int i = 0; i < 2; ++i) { const int id = tid + i * 512, row = id >> 3, c = (id & 7) ^ (row & 7); bp[i] = (const char*)(Bt + (size_t)row * ldb) + c * 16; }
    f32x4 acc[4][4];
#pragma unroll
    for (int m = 0; m < 4; ++m)
#pragma unroll
        for (int n = 0; n < 4; ++n) acc[m][n] = f32x4{0.f, 0.f, 0.f, 0.f};
    const int nt = K / 64;
    auto stage = [&](int t, int buf) {
        char* sa = smem + buf * 32768; char* sb = smem + 65536 + buf * 16384;
#pragma unroll
        for (int i = 0; i < 4; ++i) GLDS16(ap[i] + (size_t)t * 128, sa + (tid + i * 512) * 16);
#pragma unroll
        for (int i = 0; i < 2; ++i) GLDS16(bp[i] + (size_t)t * 128, sb + (tid + i * 512) * 16);
    };
    stage(0, 0);
    for (int t = 0; t < nt; ++t) {
        WAIT_VM0();
        __syncthreads();
        if (t + 1 < nt) stage(t + 1, (t + 1) & 1);
        const char* sa = smem + (t & 1) * 32768; const char* sb = smem + 65536 + (t & 1) * 16384;
#pragma unroll
        for (int kk = 0; kk < 2; ++kk) {
            bf16x8 af[4], bfr[4];
#pragma unroll
            for (int m = 0; m < 4; ++m) { const int row = wr * 64 + m * 16 + fr; af[m] = *(const bf16x8*)(sa + row * 128 + (((kk * 4 + fq) ^ (row & 7)) << 4)); }
#pragma unroll
            for (int n = 0; n < 4; ++n) { const int row = wc * 64 + n * 16 + fr; bfr[n] = *(const bf16x8*)(sb + row * 128 + (((kk * 4 + fq) ^ (row & 7)) << 4)); }
#pragma unroll
            for (int m = 0; m < 4; ++m)
#pragma unroll
                for (int n = 0; n < 4; ++n) acc[m][n] = MFMA16(af[m], bfr[n], acc[m][n]);
        }
    }
    epi(acc, wr, wc, fr, fq);
    __syncthreads();
}
template <class F> __device__ __forceinline__ void epi_each(f32x4 (&acc)[4][4], int wr, int wc, int fr, int fq, F f) {
#pragma unroll
    for (int m = 0; m < 4; ++m)
#pragma unroll
        for (int n = 0; n < 4; ++n)
#pragma unroll
            for (int j = 0; j < 4; ++j) f(wr * 64 + m * 16 + fq * 4 + j, wc * 64 + n * 16 + fr, acc[m][n][j]);
}

struct TJob { const float* src; bf16_t* dst; int K, N, Npad, nmat, perm; };
__device__ __forceinline__ void transpose_tile(char* smem, const TJob& J, int mat, int kt, int ntile) {
    float* s = (float*)smem;
    const float* src = J.src + (size_t)mat * J.K * J.N;
    bf16_t* dst = J.dst + (size_t)mat * J.Npad * J.K;
    const int tid = threadIdx.x;
#pragma unroll
    for (int i = 0; i < 8; ++i) { const int e = tid + i * 512, kr = e >> 6, nc = e & 63, n = ntile * 64 + nc; s[kr * 65 + nc] = (n < J.N) ? src[(size_t)(kt * 64 + kr) * J.N + n] : 0.f; }
    __syncthreads();
#pragma unroll
    for (int i = 0; i < 4; ++i) {
        const int e = tid + i * 512, nr = e >> 5, kp = (e & 31) * 2;
        int srcc = nr;
        if (J.perm) { const int blk = nr & ~31, w = nr & 31; srcc = blk | ((w & 15) << 1) | (w >> 4); }
        const unsigned v = pack2bf(s[kp * 65 + srcc], s[(kp + 1) * 65 + srcc]);
        *(unsigned*)(dst + (size_t)(ntile * 64 + nr) * J.K + kt * 64 + kp) = v;
    }
    __syncthreads();
}
__device__ __forceinline__ void modvec_item(char* smem, const Params& P, int item) {
    float* sc = (float*)smem;
    float* red = sc + (BATCH + 1) * D;
    const int tid = threadIdx.x, layer = item / (6 * D / 64), col0 = (item % (6 * D / 64)) * 64;
    for (int e = tid; e < (BATCH + 1) * D; e += NTHREADS) { const int b = e / D, k = e % D; const float v = (b < BATCH) ? P.in[I_C][b * D + k] : P.in[I_CCTX][k]; sc[e] = siluf_(v); }
    __syncthreads();
    const int cl = tid & 63, ks = tid >> 6;
    float acc[BATCH + 1];
#pragma unroll
    for (int b = 0; b <= BATCH; ++b) acc[b] = 0.f;
    const float* W = P.in[I_MODW] + (size_t)layer * D * 6 * D + col0 + cl;
    for (int k = ks * 128; k < ks * 128 + 128; ++k) {
        const float w = W[(size_t)k * 6 * D];
#pragma unroll
        for (int b = 0; b <= BATCH; ++b) acc[b] += sc[b * D + k] * w;
    }
#pragma unroll
    for (int b = 0; b <= BATCH; ++b) red[(ks * (BATCH + 1) + b) * 64 + cl] = acc[b];
    __syncthreads();
    for (int e = tid; e < (BATCH + 1) * 64; e += NTHREADS) {
        const int b = e >> 6, c = e & 63; float s = 0.f;
#pragma unroll
        for (int q = 0; q < 8; ++q) s += red[(q * (BATCH + 1) + b) * 64 + c];
        ((float*)(P.ws + WS_MODV))[((size_t)layer * (BATCH + 1) + b) * 6 * D + col0 + c] = s + P.in[I_MODB][layer * 6 * D + col0 + c];
    }
    __syncthreads();
}
__device__ void phase_prologue(char* smem, const Params& P, int bid, int nb) {
    const int n_mod = DEPTH * (6 * D / 64);
    for (int it = bid; it < n_mod; it += nb) modvec_item(smem, P, it);
    auto run = [&](const float* src, bf16_t* dst, int K, int N, int Npad, int nmat, int perm) {
        TJob J; J.src = src; J.dst = dst; J.K = K; J.N = N; J.Npad = Npad; J.nmat = nmat; J.perm = perm;
        const int tk = K / 64, tn = Npad / 64, per = tk * tn, total = per * nmat;
        for (int it = bid; it < total; it += nb) { const int mat = it / per, r = it % per; transpose_tile(smem, J, mat, r % tk, r / tk); }
    };
    run(P.in[I_EVWIN], (bf16_t*)(P.ws + WS_WEVIN), D, P_EVEN, P_EVEN_PAD, N_EVEN, 0);
    run(P.in[I_ODWIN], (bf16_t*)(P.ws + WS_WODIN), D, P_ODD, P_ODD_PAD, N_ODD, 0);
    run(P.in[I_EVWOUT], (bf16_t*)(P.ws + WS_WEVOUT), D, D, D, N_EVEN, 0);
    run(P.in[I_GLUW], (bf16_t*)(P.ws + WS_WGLU), 512, 512, 512, N_EVEN, 0);
    run(P.in[I_ODWOUT], (bf16_t*)(P.ws + WS_WODOUT), D, D, D, N_ODD, 0);
    run(P.in[I_WGU], (bf16_t*)(P.ws + WS_WGU), D, 2 * D, 2 * D, DEPTH * NE, 1);
    run(P.in[I_WDN], (bf16_t*)(P.ws + WS_WDN), D, D, D, DEPTH * NE, 0);
}

__device__ __forceinline__ void moe_offsets(const unsigned* counts, int* s_off) {
    if (threadIdx.x == 0) { int o = 0; for (int e = 0; e < NE; ++e) { s_off[e] = o; o += (int)((counts[e] + MOE_BM - 1) / MOE_BM) * MOE_BM; } s_off[NE] = o; }
    __syncthreads();
}

__device__ void phase_norm1(char* smem, const Params& P, int layer, int bid, int nb) {
    int* s_off = (int*)smem;
    if (layer > 0) moe_offsets((const unsigned*)(P.ws + WS_CNT) + (layer - 1) * NE, s_off);
    const int wid = threadIdx.x >> 6, lane = threadIdx.x & 63;
    float* H = (float*)(P.ws + WS_H); bf16_t* A = (bf16_t*)(P.ws + WS_A);
    const bf16_t* YB = (const bf16_t*)(P.ws + WS_YB);
    const float* gmix = P.in[I_NMIXG] + layer * D;
    for (int r = bid * 8 + wid; r < NT; r += nb * 8) {
        float v[16];
        if (layer == 0) {
            const float* src = (r < NT_CTX) ? P.in[I_CTX] + (size_t)r * D : P.in[I_X] + (size_t)(r - NT_CTX) * D;
#pragma unroll
            for (int i = 0; i < 4; ++i) { const float4 t = *(const float4*)(src + 256 * i + 4 * lane); v[4 * i] = t.x; v[4 * i + 1] = t.y; v[4 * i + 2] = t.z; v[4 * i + 3] = t.w; }
        } else {
#pragma unroll
            for (int i = 0; i < 4; ++i) { const float4 t = *(const float4*)(H + (size_t)r * D + 256 * i + 4 * lane); v[4 * i] = t.x; v[4 * i + 1] = t.y; v[4 * i + 2] = t.z; v[4 * i + 3] = t.w; }
            const int* te = (const int*)(P.ws + WS_TOKE) + r * 4; const int* tp = (const int*)(P.ws + WS_TOKPOS) + r * 4; const float* tg = (const float*)(P.ws + WS_TOKGATE) + r * 4;
            const float* g2 = modv(P, layer - 1, r, 5);
            float mo[16];
#pragma unroll
            for (int i = 0; i < 16; ++i) mo[i] = 0.f;
#pragma unroll
            for (int k = 0; k < 4; ++k) {
                const size_t row = (size_t)(s_off[te[k]] + tp[k]); const float g = tg[k];
#pragma unroll
                for (int i = 0; i < 4; ++i) { const u32x2 t = *(const u32x2*)(YB + row * D + 256 * i + 4 * lane);
                    mo[4 * i] += g * bf2f((bf16_t)(t[0] & 0xffff)); mo[4 * i + 1] += g * bf2f((bf16_t)(t[0] >> 16)); mo[4 * i + 2] += g * bf2f((bf16_t)(t[1] & 0xffff)); mo[4 * i + 3] += g * bf2f((bf16_t)(t[1] >> 16)); }
            }
#pragma unroll
            for (int i = 0; i < 4; ++i) { const float4 t = *(const float4*)(g2 + 256 * i + 4 * lane); v[4 * i] += t.x * mo[4 * i]; v[4 * i + 1] += t.y * mo[4 * i + 1]; v[4 * i + 2] += t.z * mo[4 * i + 2]; v[4 * i + 3] += t.w * mo[4 * i + 3]; }
        }
#pragma unroll
        for (int i = 0; i < 4; ++i) *(float4*)(H + (size_t)r * D + 256 * i + 4 * lane) = make_float4(v[4 * i], v[4 * i + 1], v[4 * i + 2], v[4 * i + 3]);
        float ss = 0.f;
#pragma unroll
        for (int i = 0; i < 16; ++i) ss += v[i] * v[i];
        ss = wave_sum(ss);
        const float rs = 1.f / sqrtf(ss * (1.f / D) + 1e-6f);
        const float* sh = modv(P, layer, r, 0); const float* sc = modv(P, layer, r, 1);
#pragma unroll
        for (int i = 0; i < 4; ++i) {
            const int c = 256 * i + 4 * lane; const float4 g = *(const float4*)(gmix + c), s1 = *(const float4*)(sh + c), s2 = *(const float4*)(sc + c);
            const float a0 = v[4 * i] * rs * g.x * (1.f + s2.x) + s1.x, a1 = v[4 * i + 1] * rs * g.y * (1.f + s2.y) + s1.y, a2 = v[4 * i + 2] * rs * g.z * (1.f + s2.z) + s1.z, a3 = v[4 * i + 3] * rs * g.w * (1.f + s2.w) + s1.w;
            *(u32x2*)(A + (size_t)r * D + c) = u32x2{pack2bf(a0, a1), pack2bf(a2, a3)};
        }
    }
}

template <class Epi>
__device__ __forceinline__ void phase_gemm_dense(char* smem, const bf16_t* A, int lda, const bf16_t* Bt, int K, int M, int Npad, int bid, int nb, Epi epi) {
    const int tn = Npad / 128, total = (M / 256) * tn;
    for (int it = bid; it < total; it += nb) {
        const int pm = it / tn, pn = it % tn;
        gemm_tile(smem, [&](int r) { return A + (size_t)(pm * 256 + r) * lda; }, Bt + (size_t)pn * 128 * K, K, K,
                  [&](f32x4 (&acc)[4][4], int wr, int wc, int fr, int fq) { epi(acc, wr, wc, fr, fq, pm * 256, pn * 128); });
    }
}

__device__ __forceinline__ int vstep_row(int b, int dir, int v, bool colmajor) {
    if (v < CTXL) { const int t = dir ? CTXL - 1 - v : v; return b * CTXL + t; }
    int j = v - CTXL; if (dir) j = SEQ - 1 - j;
    const int t = colmajor ? (j % GROWS) * GRID_W + (j / GROWS) : j;
    return NT_CTX + b * SEQ + t;
}

__device__ void phase_conv(const Params& P, int j, int bid, int nb) {
    const bf16_t* Z = (const bf16_t*)(P.ws + WS_Z); bf16_t* QK = (bf16_t*)(P.ws + WS_QK);
    const float* cw = P.in[I_EVCONVW] + (size_t)j * 3 * D; const float* cb = P.in[I_EVCONVB] + (size_t)j * D;
    for (int e = bid * NTHREADS + threadIdx.x; e < NT * 128; e += nb * NTHREADS) {
        const int r = e >> 7, c0 = (e & 127) * 8;
        int t, L; if (r < NT_CTX) { t = r % CTXL; L = CTXL; } else { t = (r - NT_CTX) % SEQ; L = SEQ; }
        const u32x4 zero = u32x4{0u, 0u, 0u, 0u};
        const u32x4 xc = *(const u32x4*)(Z + (size_t)r * ZLD + c0);
        const u32x4 xp = (t > 0) ? *(const u32x4*)(Z + (size_t)(r - 1) * ZLD + c0) : zero;
        const u32x4 xn = (t < L - 1) ? *(const u32x4*)(Z + (size_t)(r + 1) * ZLD + c0) : zero;
        const float sc = (c0 < 512) ? 0.08838834764831845f : 1.f;
        unsigned o[4];
#pragma unroll
        for (int q = 0; q < 4; ++q) {
            float y[2];
#pragma unroll
            for (int hh = 0; hh < 2; ++hh) {
                const int c = c0 + 2 * q + hh;
                const float a = bf2f((bf16_t)(hh ? (xp[q] >> 16) : (xp[q] & 0xffff))), b = bf2f((bf16_t)(hh ? (xc[q] >> 16) : (xc[q] & 0xffff))), d = bf2f((bf16_t)(hh ? (xn[q] >> 16) : (xn[q] & 0xffff)));
                const float v = cb[c] + cw[c] * a + cw[D + c] * b + cw[2 * D + c] * d;
                y[hh] = siluf_(v) * sc;
            }
            o[q] = pack2bf(y[0], y[1]);
        }
        *(u32x4*)(QK + (size_t)r * D + c0) = u32x4{o[0], o[1], o[2], o[3]};
    }
}

constexpr int ML_LDQ = 136, ML_LDS = 72;
constexpr int ML_OFF_Q = 0, ML_OFF_K = ML_OFF_Q + 64 * ML_LDQ * 2, ML_OFF_VT = ML_OFF_K + 64 * ML_LDQ * 2, ML_OFF_P = ML_OFF_VT + 80 * ML_LDS * 2,
              ML_OFF_KW = ML_OFF_P + 64 * ML_LDS * 2, ML_OFF_CT = ML_OFF_KW + 128 * ML_LDS * 2, ML_OFF_F = ML_OFF_CT + 80 * ML_LDQ * 2, ML_LDS_BYTES = ML_OFF_F + 5 * 64 * 4;
__device__ void phase_mlstm(char* smem, const Params& P, int bid, int nb) {
    const int tid = threadIdx.x, wid = tid >> 6, lane = tid & 63, fr = lane & 15, fq = lane >> 4;
    bf16_t* sQ = (bf16_t*)(smem + ML_OFF_Q); bf16_t* sK = (bf16_t*)(smem + ML_OFF_K); bf16_t* sVt = (bf16_t*)(smem + ML_OFF_VT); bf16_t* sP = (bf16_t*)(smem + ML_OFF_P);
    bf16_t* sKw = (bf16_t*)(smem + ML_OFF_KW); bf16_t* sCt = (bf16_t*)(smem + ML_OFF_CT);
    float* sBc = (float*)(smem + ML_OFF_F); float* sIg = sBc + 64; float* sWg = sBc + 128; float* sDen = sBc + 192; float* sEb = sBc + 256;
    const bf16_t* QK = (const bf16_t*)(P.ws + WS_QK); const bf16_t* Z = (const bf16_t*)(P.ws + WS_Z); const float* G = (const float*)(P.ws + WS_GATES);
    float* MO = (float*)(P.ws + WS_MO);
    for (int it = bid; it < BATCH * 16; it += nb) {
        const int hf = it & 1, dir = (it >> 1) & 1, head = (it >> 2) & 3, b = it >> 4;
        for (int e = tid; e < 80 * ML_LDQ; e += NTHREADS) sCt[e] = 0;
        for (int e = tid; e < 16 * ML_LDS; e += NTHREADS) sVt[64 * ML_LDS + e] = (e < 64) ? (bf16_t)0x3F80 : (bf16_t)0;
        f32x4 Cacc[5];
#pragma unroll
        for (int n = 0; n < 5; ++n) Cacc[n] = f32x4{0.f, 0.f, 0.f, 0.f};
        __syncthreads();
        for (int ci = 0; ci < NCH; ++ci) {
#pragma unroll
            for (int i = 0; i < 2; ++i) {
                const int id = tid + i * 512, s = id >> 4, ch = id & 15; const int row = vstep_row(b, dir, ci * 64 + s, false);
                *(u32x4*)(sQ + s * ML_LDQ + ch * 8) = *(const u32x4*)(QK + (size_t)row * D + head * 128 + ch * 8);
                *(u32x4*)(sK + s * ML_LDQ + ch * 8) = *(const u32x4*)(QK + (size_t)row * D + 512 + head * 128 + ch * 8);
            }
            {
                const int s = tid >> 3, ch = tid & 7; const int row = vstep_row(b, dir, ci * 64 + s, false);
                const u32x4 v = *(const u32x4*)(Z + (size_t)row * ZLD + 1024 + head * 128 + hf * 64 + ch * 8);
#pragma unroll
                for (int q = 0; q < 4; ++q) { sVt[(ch * 8 + 2 * q) * ML_LDS + s] = (bf16_t)(v[q] & 0xffff); sVt[(ch * 8 + 2 * q + 1) * ML_LDS + s] = (bf16_t)(v[q] >> 16); }
            }
            if (wid == 0) {
                const int row = vstep_row(b, dir, ci * 64 + lane, false);
                const float ig = G[(size_t)row * 32 + (dir * 2) * 4 + head];
                float c = logsigmoidf_(G[(size_t)row * 32 + (dir * 2 + 1) * 4 + head]);
                for (int d = 1; d < 64; d <<= 1) { const float n = __shfl_up(c, d); if (lane >= d) c += n; }
                const float bl = __shfl(c, 63);
                sBc[lane] = c; sIg[lane] = ig; sWg[lane] = __expf(bl - c + ig); sEb[lane] = __expf(c);
            }
            __syncthreads();
            {
                const int tt = wid >> 1;
#pragma unroll
                for (int u = 0; u < 2; ++u) {
                    const int st = (wid & 1) * 2 + u;
                    f32x4 acc = f32x4{0.f, 0.f, 0.f, 0.f};
#pragma unroll
                    for (int kk = 0; kk < 4; ++kk) {
                        const bf16x8 a = *(const bf16x8*)(sQ + (tt * 16 + fr) * ML_LDQ + kk * 32 + fq * 8);
                        const bf16x8 bb = *(const bf16x8*)(sK + (st * 16 + fr) * ML_LDQ + kk * 32 + fq * 8);
                        acc = MFMA16(a, bb, acc);
                    }
                    const int s = st * 16 + fr; const float bs = sBc[s], is = sIg[s];
#pragma unroll
                    for (int j = 0; j < 4; ++j) { const int t = tt * 16 + fq * 4 + j; const float w = (s <= t) ? __expf(sBc[t] - bs + is) : 0.f; sP[t * ML_LDS + s] = f2bf(acc[j] * w); }
                }
#pragma unroll
                for (int i = 0; i < 16; ++i) { const int e = tid + i * 512, s = e & 63, d = e >> 6; sKw[d * ML_LDS + s] = f2bf(bf2f(sK[s * ML_LDQ + d]) * sWg[s]); }
            }
            __syncthreads();
            const int tt = wid & 3, e0 = (wid < 4) ? 0 : 3, ne = (wid < 4) ? 3 : 2;
            f32x4 val[3];
#pragma unroll
            for (int u = 0; u < 3; ++u) {
                val[u] = f32x4{0.f, 0.f, 0.f, 0.f};
                if (u < ne) {
                    const int et = e0 + u;
                    f32x4 ai = f32x4{0.f, 0.f, 0.f, 0.f}, ao = f32x4{0.f, 0.f, 0.f, 0.f};
#pragma unroll
                    for (int kk = 0; kk < 2; ++kk) {
                        const bf16x8 a = *(const bf16x8*)(sP + (tt * 16 + fr) * ML_LDS + kk * 32 + fq * 8);
                        const bf16x8 bb = *(const bf16x8*)(sVt + (et * 16 + fr) * ML_LDS + kk * 32 + fq * 8);
                        ai = MFMA16(a, bb, ai);
                    }
#pragma unroll
                    for (int kk = 0; kk < 4; ++kk) {
                        const bf16x8 a = *(const bf16x8*)(sQ + (tt * 16 + fr) * ML_LDQ + kk * 32 + fq * 8);
                        const bf16x8 bb = *(const bf16x8*)(sCt + (et * 16 + fr) * ML_LDQ + kk * 32 + fq * 8);
                        ao = MFMA16(a, bb, ao);
                    }
#pragma unroll
                    for (int j = 0; j < 4; ++j) val[u][j] = ai[j] + sEb[tt * 16 + fq * 4 + j] * ao[j];
                    if (et == 4 && fr == 0) {
#pragma unroll
                        for (int j = 0; j < 4; ++j) sDen[tt * 16 + fq * 4 + j] = val[u][j];
                    }
                }
            }
            __syncthreads();
#pragma unroll
            for (int u = 0; u < 3; ++u) {
                const int et = e0 + u;
                if (u < ne && et < 4) {
#pragma unroll
                    for (int j = 0; j < 4; ++j) {
                        const int t = tt * 16 + fq * 4 + j; const int row = vstep_row(b, dir, ci * 64 + t, false);
                        const float dn = fmaxf(fabsf(sDen[t]), 1.f);
                        MO[((size_t)dir * NT + row) * D + head * 128 + hf * 64 + et * 16 + fr] = val[u][j] / dn;
                    }
                }
            }
            {
                const float dec = sEb[63];
#pragma unroll
                for (int n = 0; n < 5; ++n) {
                    f32x4 c = Cacc[n] * dec;
#pragma unroll
                    for (int kk = 0; kk < 2; ++kk) {
                        const bf16x8 a = *(const bf16x8*)(sKw + (wid * 16 + fr) * ML_LDS + kk * 32 + fq * 8);
                        const bf16x8 bb = *(const bf16x8*)(sVt + (n * 16 + fr) * ML_LDS + kk * 32 + fq * 8);
                        c = MFMA16(a, bb, c);
                    }
                    Cacc[n] = c;
                    *(u32x2*)(sCt + (n * 16 + fr) * ML_LDQ + wid * 16 + fq * 4) = u32x2{pack2bf(c[0], c[1]), pack2bf(c[2], c[3])};
                }
            }
            __syncthreads();
        }
    }
}

#ifdef HOST_EMU
#define WAVE_SYNC() do { int _z = 0; (void)emu::wave_exchange(&_z, 4); } while (0)
#else
#define WAVE_SYNC() __builtin_amdgcn_wave_barrier()
#endif

constexpr int S5_LDW = 132;
constexpr int S5_WAVE_BYTES = 32 * S5_LDW * 4 + 128 * 4, S5_LDS_BYTES = 8 * S5_WAVE_BYTES;
__device__ void phase_s5(char* smem, const Params& P, int j, int bid, int nb) {
    const int tid = threadIdx.x, wid = tid >> 6, lane = tid & 63, fr = lane & 15, fq = lane >> 4;
    float* BU = (float*)(smem + wid * S5_WAVE_BYTES); float* sZ = BU + 32 * S5_LDW;
    const bf16_t* Z = (const bf16_t*)(P.ws + WS_Z); float* MO = (float*)(P.ws + WS_MO);
    for (int it = bid * 8 + wid; it < BATCH * 2 * 32; it += nb * 8) {
        const int g = it & 31, dir = (it >> 5) & 1, b = it >> 6;
        const float* are = P.in[dir ? I_AREB : I_AREF] + ((size_t)j * 32 + g) * 64; const float* aim = P.in[dir ? I_AIMB : I_AIMF] + ((size_t)j * 32 + g) * 64;
        const float dt = expf(P.in[dir ? I_LDTB : I_LDTF][j * 32 + g]);
        const float lre = fminf(are[lane], -1e-4f), lim = aim[lane];
        const float dec = expf(lre * dt), abr = dec * cosf(lim * dt), abi = dec * sinf(lim * dt);
        const float den = lre * lre + lim * lim;
        const float zr = ((abr - 1.f) * lre + abi * lim) / den, zi = (abi * lre - (abr - 1.f) * lim) / den;
        sZ[lane] = zr; sZ[64 + lane] = zi;
        WAVE_SYNC();
        bf16x8 bop[4];
        {
            const float* bre = P.in[I_S5BRE] + ((size_t)j * 32 + g) * 64 * 16; const float* bim = P.in[I_S5BIM] + ((size_t)j * 32 + g) * 64 * 16;
#pragma unroll
            for (int nt = 0; nt < 4; ++nt) {
                const int comp = nt * 32 + (lane & 31); const float* src = (comp < 64 ? bre + comp * 16 : bim + (comp - 64) * 16) + 8 * (lane >> 5);
#pragma unroll
                for (int q = 0; q < 8; ++q) bop[nt][q] = (short)f2bf(src[q]);
            }
        }
        bf16x8 cop[4];
        {
            const float* cre = P.in[I_S5CRE] + (((size_t)j * 32 + g) * 16 + fr) * 64; const float* cim = P.in[I_S5CIM] + (((size_t)j * 32 + g) * 16 + fr) * 64;
#pragma unroll
            for (int kk = 0; kk < 4; ++kk)
#pragma unroll
                for (int q = 0; q < 8; ++q) {
                    const int comp = kk * 32 + 8 * fq + q, p = comp & 63; const float cr = cre[p], cimv = cim[p], zrp = sZ[p], zip = sZ[64 + p];
                    const float v = (comp < 64) ? (cr * zrp - cimv * zip) : -(cr * zip + cimv * zrp);
                    cop[kk][q] = (short)f2bf(v);
                }
        }
        float sre = 0.f, sim = 0.f;
        for (int c32 = 0; c32 < (CTXL + SEQ) / 32; ++c32) {
            const int rowA = vstep_row(b, dir, c32 * 32 + (lane & 31), false);
            const bf16x8 ua = *(const bf16x8*)(Z + (size_t)rowA * ZLD + 2064 + g * 16 + 8 * (lane >> 5));
#pragma unroll
            for (int nt = 0; nt < 4; ++nt) {
                f32x16 d;
#pragma unroll
                for (int q = 0; q < 16; ++q) d[q] = 0.f;
                d = MFMA32(ua, bop[nt], d);
#pragma unroll
                for (int q = 0; q < 16; ++q) BU[((q & 3) + 8 * (q >> 2) + 4 * (lane >> 5)) * S5_LDW + nt * 32 + (lane & 31)] = d[q];
            }
            WAVE_SYNC();
#pragma unroll 4
            for (int s = 0; s < 32; ++s) {
                const float br = BU[s * S5_LDW + lane], bi = BU[s * S5_LDW + 64 + lane];
                const float nr = abr * sre - abi * sim + br, ni = abr * sim + abi * sre + bi;
                sre = nr; sim = ni;
                BU[s * S5_LDW + lane] = nr; BU[s * S5_LDW + 64 + lane] = ni;
            }
            WAVE_SYNC();
#pragma unroll
            for (int mt = 0; mt < 2; ++mt) {
                f32x4 acc = f32x4{0.f, 0.f, 0.f, 0.f};
#pragma unroll
                for (int kk = 0; kk < 4; ++kk) {
                    const float* sp = BU + (mt * 16 + fr) * S5_LDW + kk * 32 + fq * 8;
                    const float4 x0 = *(const float4*)sp, x1 = *(const float4*)(sp + 4);
                    bf16x8 a; a[0] = (short)f2bf(x0.x); a[1] = (short)f2bf(x0.y); a[2] = (short)f2bf(x0.z); a[3] = (short)f2bf(x0.w);
                    a[4] = (short)f2bf(x1.x); a[5] = (short)f2bf(x1.y); a[6] = (short)f2bf(x1.z); a[7] = (short)f2bf(x1.w);
                    acc = MFMA16(a, cop[kk], acc);
                }
#pragma unroll
                for (int q = 0; q < 4; ++q) { const int row = vstep_row(b, dir, c32 * 32 + mt * 16 + fq * 4 + q, false); MO[((size_t)dir * NT + row) * D + 512 + g * 16 + fr] = acc[q]; }
            }
            WAVE_SYNC();
        }
    }
}

__device__ void phase_post_even(const Params& P, int j, int bid, int nb) {
    const int wid = threadIdx.x >> 6, lane = threadIdx.x & 63;
    const float* MO = (const float*)(P.ws + WS_MO); const bf16_t* Z = (const bf16_t*)(P.ws + WS_Z);
    bf16_t* CAT = (bf16_t*)(P.ws + WS_CAT); bf16_t* YY = (bf16_t*)(P.ws + WS_YY);
    const float* mg = P.in[I_EVMNORM] + (size_t)j * 512; const float* dsk = P.in[I_S5D] + (size_t)j * 512;
    for (int r = bid * 8 + wid; r < NT; r += nb * 8) {
        const int c0 = lane * 8;
        float m[8], s[8];
        {
            const float* a = MO + (size_t)r * D + c0; const float* bq = MO + ((size_t)NT + r) * D + c0;
#pragma unroll
            for (int q = 0; q < 8; ++q) { m[q] = a[q] + bq[q]; s[q] = a[512 + q] + bq[512 + q]; }
        }
        float ss = 0.f;
#pragma unroll
        for (int q = 0; q < 8; ++q) ss += m[q] * m[q];
        ss = group16_sum(ss);
        const float rs = 1.f / sqrtf(ss * (1.f / 128.f) + 1e-6f);
        const u32x4 ov = *(const u32x4*)(Z + (size_t)r * ZLD + 1536 + c0);
        const u32x4 uv = *(const u32x4*)(Z + (size_t)r * ZLD + 2064 + c0);
        unsigned o1[4], o2[4];
#pragma unroll
        for (int q = 0; q < 4; ++q) {
            const float oa = bf2f((bf16_t)(ov[q] & 0xffff)), ob = bf2f((bf16_t)(ov[q] >> 16));
            const float ua = bf2f((bf16_t)(uv[q] & 0xffff)), ub = bf2f((bf16_t)(uv[q] >> 16));
            const float ma = m[2 * q] * rs * mg[c0 + 2 * q] * sigmoidf_(oa), mb = m[2 * q + 1] * rs * mg[c0 + 2 * q + 1] * sigmoidf_(ob);
            const float ya = gelu_tanhf_(s[2 * q] + dsk[c0 + 2 * q] * ua), yb = gelu_tanhf_(s[2 * q + 1] + dsk[c0 + 2 * q + 1] * ub);
            o1[q] = pack2bf(ma, mb); o2[q] = pack2bf(ya, yb);
        }
        *(u32x4*)(CAT + (size_t)r * D + c0) = u32x4{o1[0], o1[1], o1[2], o1[3]};
        *(u32x4*)(YY + (size_t)r * 512 + c0) = u32x4{o2[0], o2[1], o2[2], o2[3]};
    }
}

__device__ void phase_post_odd(const Params& P, int j, int bid, int nb) {
    const int wid = threadIdx.x >> 6, lane = threadIdx.x & 63;
    const float* MO = (const float*)(P.ws + WS_MO); const bf16_t* Z = (const bf16_t*)(P.ws + WS_Z); bf16_t* CAT = (bf16_t*)(P.ws + WS_CAT);
    const float* ng = P.in[I_ODNORM] + (size_t)j * D;
    for (int r = bid * 8 + wid; r < NT; r += nb * 8) {
        const int c0 = lane * 16;
        float o[16];
        {
            const float* a = MO + (size_t)r * D + c0; const float* bq = MO + ((size_t)NT + r) * D + c0;
#pragma unroll
            for (int q = 0; q < 16; ++q) o[q] = a[q] + bq[q];
        }
        float ss = 0.f;
#pragma unroll
        for (int q = 0; q < 16; ++q) ss += o[q] * o[q];
        ss = group16_sum(ss);
        const float rs = 1.f / sqrtf(ss * (1.f / 256.f) + 1e-6f);
#pragma unroll
        for (int hh = 0; hh < 2; ++hh) {
            const u32x4 gv = *(const u32x4*)(Z + (size_t)r * ZLD + 2048 + c0 + hh * 8);
            unsigned w[4];
#pragma unroll
            for (int q = 0; q < 4; ++q) {
                const int c = c0 + hh * 8 + 2 * q;
                const float ga = bf2f((bf16_t)(gv[q] & 0xffff)), gb = bf2f((bf16_t)(gv[q] >> 16));
                w[q] = pack2bf(o[hh * 8 + 2 * q] * rs * ng[c] * siluf_(ga), o[hh * 8 + 2 * q + 1] * rs * ng[c + 1] * siluf_(gb));
            }
            *(u32x4*)(CAT + (size_t)r * D + c0 + hh * 8) = u32x4{w[0], w[1], w[2], w[3]};
        }
    }
}

constexpr int GL_LDQ = 136, GL_LDS = 72, GL_LDB = 129;
constexpr int GL_OFF_Q = 0, GL_OFF_K = GL_OFF_Q + 64 * GL_LDQ * 2, GL_OFF_KD = GL_OFF_K + 64 * GL_LDQ * 2, GL_OFF_VT = GL_OFF_KD + 128 * GL_LDS * 2, GL_OFF_P = GL_OFF_VT + 128 * GL_LDS * 2,
              GL_OFF_ST = GL_OFF_P + 64 * GL_LDS * 2, GL_OFF_B = GL_OFF_ST + 128 * GL_LDQ * 2, GL_OFF_R = GL_OFF_B + 64 * GL_LDB * 4, GL_OFF_TOT = GL_OFF_R + 64 * 16 * 4, GL_LDS_BYTES = GL_OFF_TOT + 4 * 128 * 4;
__device__ void phase_gla(char* smem, const Params& P, int j, int bid, int nb) {
    const int tid = threadIdx.x, wid = tid >> 6, lane = tid & 63, fr = lane & 15, fq = lane >> 4;
    bf16_t* sQ = (bf16_t*)(smem + GL_OFF_Q); bf16_t* sK = (bf16_t*)(smem + GL_OFF_K); bf16_t* sKd = (bf16_t*)(smem + GL_OFF_KD); bf16_t* sVt = (bf16_t*)(smem + GL_OFF_VT);
    bf16_t* sP = (bf16_t*)(smem + GL_OFF_P); bf16_t* sSt = (bf16_t*)(smem + GL_OFF_ST); float* sB = (float*)(smem + GL_OFF_B); float* sR = (float*)(smem + GL_OFF_R); float* sTot = (float*)(smem + GL_OFF_TOT);
    const bf16_t* Z = (const bf16_t*)(P.ws + WS_Z); const float* G = (const float*)(P.ws + WS_GATES); float* MO = (float*)(P.ws + WS_MO);
    for (int it = bid; it < BATCH * 16; it += nb) {
        const int hf = it & 1, dir = (it >> 1) & 1, head = (it >> 2) & 3, b = it >> 4;
        const float* w2 = P.in[dir ? I_ODW2B : I_ODW2F] + (size_t)j * 16 * 512; const float* b2 = P.in[dir ? I_ODB2B : I_ODB2F] + (size_t)j * 512;
        const int dcol = tid & 127, sg = tid >> 7;
        float w2c[16];
#pragma unroll
        for (int q = 0; q < 16; ++q) w2c[q] = w2[q * 512 + head * 128 + dcol];
        const float b2c = b2[head * 128 + dcol];
        for (int e = tid; e < 128 * GL_LDQ; e += NTHREADS) sSt[e] = 0;
        f32x4 Sacc[8];
#pragma unroll
        for (int n = 0; n < 8; ++n) Sacc[n] = f32x4{0.f, 0.f, 0.f, 0.f};
        __syncthreads();
        for (int ci = 0; ci < NCH; ++ci) {
            if (tid < 256) { const int s = tid >> 2, q4 = tid & 3; const int row = vstep_row(b, dir, ci * 64 + s, true); *(float4*)(sR + s * 16 + q4 * 4) = *(const float4*)(G + (size_t)row * 32 + dir * 16 + q4 * 4); }
            __syncthreads();
            float la[16]; float run = 0.f;
#pragma unroll
            for (int i = 0; i < 16; ++i) {
                const int s = sg * 16 + i; float x = b2c;
#pragma unroll
                for (int q = 0; q < 16; ++q) x += sR[s * 16 + q] * w2c[q];
                run += logsigmoidf_(x) * (1.f / 16.f); la[i] = run;
            }
            sTot[sg * 128 + dcol] = run;
            __syncthreads();
            {
                float pre = 0.f;
#pragma unroll
                for (int q = 0; q < 3; ++q) if (q < sg) pre += sTot[q * 128 + dcol];
#pragma unroll
                for (int i = 0; i < 16; ++i) sB[(sg * 16 + i) * GL_LDB + dcol] = la[i] + pre;
            }
            __syncthreads();
#pragma unroll
            for (int i = 0; i < 2; ++i) {
                const int id = tid + i * 512, s = id >> 4, ch = id & 15; const int row = vstep_row(b, dir, ci * 64 + s, true);
                const u32x4 qv = *(const u32x4*)(Z + (size_t)row * ZLD + head * 128 + ch * 8);
                const u32x4 kv = *(const u32x4*)(Z + (size_t)row * ZLD + 512 + head * 128 + ch * 8);
                const u32x4 vv = *(const u32x4*)(Z + (size_t)row * ZLD + 1024 + head * 256 + hf * 128 + ch * 8);
                unsigned qo[4], ko[4];
#pragma unroll
                for (int q = 0; q < 4; ++q) {
                    const int d0 = ch * 8 + 2 * q;
                    const float bA = sB[s * GL_LDB + d0], bB = sB[s * GL_LDB + d0 + 1], lA = sB[63 * GL_LDB + d0], lB = sB[63 * GL_LDB + d0 + 1];
                    const float qa = bf2f((bf16_t)(qv[q] & 0xffff)) * 0.08838834764831845f, qb = bf2f((bf16_t)(qv[q] >> 16)) * 0.08838834764831845f;
                    const float ka = bf2f((bf16_t)(kv[q] & 0xffff)), kb = bf2f((bf16_t)(kv[q] >> 16));
                    qo[q] = pack2bf(qa * __expf(bA), qb * __expf(bB)); ko[q] = pack2bf(ka * __expf(-bA), kb * __expf(-bB));
                    sKd[d0 * GL_LDS + s] = f2bf(ka * __expf(lA - bA)); sKd[(d0 + 1) * GL_LDS + s] = f2bf(kb * __expf(lB - bB));
                    sVt[d0 * GL_LDS + s] = (bf16_t)(vv[q] & 0xffff); sVt[(d0 + 1) * GL_LDS + s] = (bf16_t)(vv[q] >> 16);
                }
                *(u32x4*)(sQ + s * GL_LDQ + ch * 8) = u32x4{qo[0], qo[1], qo[2], qo[3]};
                *(u32x4*)(sK + s * GL_LDQ + ch * 8) = u32x4{ko[0], ko[1], ko[2], ko[3]};
            }
            __syncthreads();
            {
                const int tt = wid >> 1;
#pragma unroll
                for (int u = 0; u < 2; ++u) {
                    const int st = (wid & 1) * 2 + u;
                    f32x4 acc = f32x4{0.f, 0.f, 0.f, 0.f};
#pragma unroll
                    for (int kk = 0; kk < 4; ++kk) {
                        const bf16x8 a = *(const bf16x8*)(sQ + (tt * 16 + fr) * GL_LDQ + kk * 32 + fq * 8);
                        const bf16x8 bb = *(const bf16x8*)(sK + (st * 16 + fr) * GL_LDQ + kk * 32 + fq * 8);
                        acc = MFMA16(a, bb, acc);
                    }
                    const int s = st * 16 + fr;
#pragma unroll
                    for (int q = 0; q < 4; ++q) { const int t = tt * 16 + fq * 4 + q; sP[t * GL_LDS + s] = f2bf((s <= t) ? acc[q] : 0.f); }
                }
            }
            __syncthreads();
            {
                const int tt = wid & 3;
#pragma unroll
                for (int u = 0; u < 4; ++u) {
                    const int et = (wid >> 2) * 4 + u;
                    f32x4 acc = f32x4{0.f, 0.f, 0.f, 0.f};
#pragma unroll
                    for (int kk = 0; kk < 2; ++kk) {
                        const bf16x8 a = *(const bf16x8*)(sP + (tt * 16 + fr) * GL_LDS + kk * 32 + fq * 8);
                        const bf16x8 bb = *(const bf16x8*)(sVt + (et * 16 + fr) * GL_LDS + kk * 32 + fq * 8);
                        acc = MFMA16(a, bb, acc);
                    }
#pragma unroll
                    for (int kk = 0; kk < 4; ++kk) {
                        const bf16x8 a = *(const bf16x8*)(sQ + (tt * 16 + fr) * GL_LDQ + kk * 32 + fq * 8);
                        const bf16x8 bb = *(const bf16x8*)(sSt + (et * 16 + fr) * GL_LDQ + kk * 32 + fq * 8);
                        acc = MFMA16(a, bb, acc);
                    }
#pragma unroll
                    for (int q = 0; q < 4; ++q) { const int t = tt * 16 + fq * 4 + q; const int row = vstep_row(b, dir, ci * 64 + t, true); MO[((size_t)dir * NT + row) * D + head * 256 + hf * 128 + et * 16 + fr] = acc[q]; }
                }
            }
            __syncthreads();
            {
                float dec[4];
#pragma unroll
                for (int q = 0; q < 4; ++q) dec[q] = __expf(sB[63 * GL_LDB + wid * 16 + fq * 4 + q]);
#pragma unroll
                for (int n = 0; n < 8; ++n) {
                    f32x4 c = Sacc[n];
#pragma unroll
                    for (int q = 0; q < 4; ++q) c[q] *= dec[q];
#pragma unroll
                    for (int kk = 0; kk < 2; ++kk) {
                        const bf16x8 a = *(const bf16x8*)(sKd + (wid * 16 + fr) * GL_LDS + kk * 32 + fq * 8);
                        const bf16x8 bb = *(const bf16x8*)(sVt + (n * 16 + fr) * GL_LDS + kk * 32 + fq * 8);
                        c = MFMA16(a, bb, c);
                    }
                    Sacc[n] = c;
                    *(u32x2*)(sSt + (n * 16 + fr) * GL_LDQ + wid * 16 + fq * 4) = u32x2{pack2bf(c[0], c[1]), pack2bf(c[2], c[3])};
                }
            }
            __syncthreads();
        }
    }
}

constexpr int RT_MAX_TOK = 320;
__device__ void phase_norm2_router(char* smem, const Params& P, int layer, int bid, int nb) {
    const int tid = threadIdx.x, wid = tid >> 6, lane = tid & 63;
    int* s_cnt = (int*)smem; int* s_base = s_cnt + NE; int* s_e = s_base + NE; int* s_rank = s_e + RT_MAX_TOK * 4;
    const bool last = (layer == DEPTH - 1);
    const int r_begin = last ? NT_CTX : 0, n_act = NT - r_begin;
    const int per = (n_act + nb - 1) / nb;
    const int r0 = r_begin + bid * per, r1 = (r0 + per < NT) ? r0 + per : NT;
    if (tid < NE) s_cnt[tid] = 0;
    __syncthreads();
    const float* H = (const float*)(P.ws + WS_H); bf16_t* A = (bf16_t*)(P.ws + WS_A);
    const float* gffn = P.in[I_NFFNG] + layer * D; const float* rw = P.in[I_RW] + (size_t)layer * D * NE; const float* rb = P.in[I_RB] + layer * NE;
    for (int r = r0 + wid; r < r1; r += 8) {
        float v[16];
#pragma unroll
        for (int i = 0; i < 4; ++i) { const float4 t = *(const float4*)(H + (size_t)r * D + 256 * i + 4 * lane); v[4 * i] = t.x; v[4 * i + 1] = t.y; v[4 * i + 2] = t.z; v[4 * i + 3] = t.w; }
        float ss = 0.f;
#pragma unroll
        for (int i = 0; i < 16; ++i) ss += v[i] * v[i];
        ss = wave_sum(ss);
        const float rs = 1.f / sqrtf(ss * (1.f / D) + 1e-6f);
        const float* sh = modv(P, layer, r, 3); const float* sc = modv(P, layer, r, 4);
        float f[16];
#pragma unroll
        for (int i = 0; i < 4; ++i) {
            const int c = 256 * i + 4 * lane; const float4 g = *(const float4*)(gffn + c), s1 = *(const float4*)(sh + c), s2 = *(const float4*)(sc + c);
            f[4 * i] = v[4 * i] * rs * g.x * (1.f + s2.x) + s1.x; f[4 * i + 1] = v[4 * i + 1] * rs * g.y * (1.f + s2.y) + s1.y;
            f[4 * i + 2] = v[4 * i + 2] * rs * g.z * (1.f + s2.z) + s1.z; f[4 * i + 3] = v[4 * i + 3] * rs * g.w * (1.f + s2.w) + s1.w;
            *(u32x2*)(A + (size_t)r * D + c) = u32x2{pack2bf(f[4 * i], f[4 * i + 1]), pack2bf(f[4 * i + 2], f[4 * i + 3])};
        }
        float lg[NE];
#pragma unroll
        for (int e = 0; e < NE; ++e) lg[e] = 0.f;
#pragma unroll
        for (int i = 0; i < 16; ++i) {
            const int c = 256 * (i >> 2) + 4 * lane + (i & 3); const float* wrow = rw + (size_t)c * NE;
#pragma unroll
            for (int e4 = 0; e4 < NE / 4; ++e4) { const float4 w = *(const float4*)(wrow + 4 * e4); lg[4 * e4] += f[i] * w.x; lg[4 * e4 + 1] += f[i] * w.y; lg[4 * e4 + 2] += f[i] * w.z; lg[4 * e4 + 3] += f[i] * w.w; }
        }
#pragma unroll
        for (int e = 0; e < NE; ++e) lg[e] = wave_sum(lg[e]);
        float tv[4]; int ti[4];
#pragma unroll
        for (int e = 0; e < NE; ++e) lg[e] += rb[e];
#pragma unroll
        for (int k = 0; k < 4; ++k) {
            float best = -3.0e38f; int bi = 0;
#pragma unroll
            for (int e = 0; e < NE; ++e) { const bool take = lg[e] > best; best = take ? lg[e] : best; bi = take ? e : bi; }
            tv[k] = best; ti[k] = bi;
#pragma unroll
            for (int e = 0; e < NE; ++e) lg[e] = (e == bi) ? -3.0e38f : lg[e];
        }
        if (lane == 0) {
            const float e1 = __expf(tv[1] - tv[0]), e2 = __expf(tv[2] - tv[0]), e3 = __expf(tv[3] - tv[0]); const float inv = 1.f / (1.f + e1 + e2 + e3);
            float* tg = (float*)(P.ws + WS_TOKGATE) + (size_t)r * 4; int* te = (int*)(P.ws + WS_TOKE) + (size_t)r * 4;
            tg[0] = inv; tg[1] = e1 * inv; tg[2] = e2 * inv; tg[3] = e3 * inv;
            const int tl = r - r0;
#pragma unroll
            for (int k = 0; k < 4; ++k) { te[k] = ti[k]; s_e[tl * 4 + k] = ti[k]; s_rank[tl * 4 + k] = atomicAdd(&s_cnt[ti[k]], 1); }
        }
    }
    __syncthreads();
    if (tid < NE) s_base[tid] = (int)atomicAdd((unsigned*)(P.ws + WS_CNT) + layer * NE + tid, (unsigned)s_cnt[tid]);
    __syncthreads();
    int* RT = (int*)(P.ws + WS_ROWTOK); int* TP = (int*)(P.ws + WS_TOKPOS);
    for (int q = tid; q < (r1 - r0) * 4; q += NTHREADS) {
        const int tl = q >> 2, r = r0 + tl, e = s_e[q], pos = s_base[e] + s_rank[q];
        RT[(size_t)e * NT + pos] = r; TP[(size_t)r * 4 + (q & 3)] = pos;
    }
}

__device__ void phase_moe_gu(char* smem, const Params& P, int layer, int bid, int nb) {
    int* s_off = (int*)(smem + GEMM_LDS);
    const unsigned* counts = (const unsigned*)(P.ws + WS_CNT) + layer * NE;
    moe_offsets(counts, s_off);
    const int nrb = s_off[NE] / MOE_BM, total = nrb * 16;
    const bf16_t* A = (const bf16_t*)(P.ws + WS_A); const int* RT = (const int*)(P.ws + WS_ROWTOK);
    bf16_t* HDN = (bf16_t*)(P.ws + WS_HDN);
    for (int it = bid; it < total; it += nb) {
        const int rbg = it >> 4, cb = it & 15;
        int e = 0;
        while (e < NE - 1 && s_off[e + 1] <= rbg * MOE_BM) ++e;
        const int rb = rbg - s_off[e] / MOE_BM, cnt = (int)counts[e];
        const bf16_t* Bt = (const bf16_t*)(P.ws + WS_WGU) + ((size_t)(layer * NE + e) * 2 * D + cb * 128) * D;
        const float* bgu = P.in[I_BGU] + (size_t)(layer * NE + e) * 2 * D;
        gemm_tile(smem, [&](int r) { const int idx = rb * MOE_BM + r; const int tok = (idx < cnt) ? RT[(size_t)e * NT + idx] : 0; return A + (size_t)tok * D; }, Bt, D, D,
                  [&](f32x4 (&acc)[4][4], int wr, int wc, int fr, int fq) {
#pragma unroll
                      for (int m = 0; m < 4; ++m)
#pragma unroll
                          for (int pr = 0; pr < 2; ++pr) {
                              const int jh = (cb * 4 + wc * 2 + pr) * 16 + fr;
                              const float bg = bgu[2 * jh], bu = bgu[2 * jh + 1];
#pragma unroll
                              for (int q = 0; q < 4; ++q) {
                                  const float g = fminf(acc[m][2 * pr][q] + bg, 7.f), u = fminf(fmaxf(acc[m][2 * pr + 1][q] + bu, -7.f), 7.f);
                                  const float hv = (u + 1.f) * (g * sigmoidf_(1.702f * g));
                                  HDN[(size_t)(rbg * MOE_BM + wr * 64 + m * 16 + fq * 4 + q) * D + jh] = f2bf(hv);
                              }
                          }
                  });
    }
}
__device__ void phase_moe_down(char* smem, const Params& P, int layer, int bid, int nb) {
    int* s_off = (int*)(smem + GEMM_LDS);
    const unsigned* counts = (const unsigned*)(P.ws + WS_CNT) + layer * NE;
    moe_offsets(counts, s_off);
    const int nrb = s_off[NE] / MOE_BM, total = nrb * 8;
    const bf16_t* HDN = (const bf16_t*)(P.ws + WS_HDN); bf16_t* YB = (bf16_t*)(P.ws + WS_YB);
    for (int it = bid; it < total; it += nb) {
        const int rbg = it >> 3, cb = it & 7;
        int e = 0;
        while (e < NE - 1 && s_off[e + 1] <= rbg * MOE_BM) ++e;
        const bf16_t* Bt = (const bf16_t*)(P.ws + WS_WDN) + ((size_t)(layer * NE + e) * D + cb * 128) * D;
        const float* bd = P.in[I_BDN] + (size_t)(layer * NE + e) * D + cb * 128;
        gemm_tile(smem, [&](int r) { return HDN + (size_t)(rbg * MOE_BM + r) * D; }, Bt, D, D,
                  [&](f32x4 (&acc)[4][4], int wr, int wc, int fr, int fq) {
                      epi_each(acc, wr, wc, fr, fq, [&](int r, int c, float v) { YB[(size_t)(rbg * MOE_BM + r) * D + cb * 128 + c] = f2bf(v + bd[c]); });
                  });
    }
}

__device__ void phase_final(char* smem, const Params& P, int bid, int nb) {
    int* s_off = (int*)smem;
    moe_offsets((const unsigned*)(P.ws + WS_CNT) + (DEPTH - 1) * NE, s_off);
    const int wid = threadIdx.x >> 6, lane = threadIdx.x & 63;
    const float* H = (const float*)(P.ws + WS_H); const bf16_t* YB = (const bf16_t*)(P.ws + WS_YB); const float* fg = P.in[I_FNORM];
    for (int r = NT_CTX + bid * 8 + wid; r < NT; r += nb * 8) {
        float v[16], mo[16];
#pragma unroll
        for (int i = 0; i < 4; ++i) { const float4 t = *(const float4*)(H + (size_t)r * D + 256 * i + 4 * lane); v[4 * i] = t.x; v[4 * i + 1] = t.y; v[4 * i + 2] = t.z; v[4 * i + 3] = t.w; }
        const int* te = (const int*)(P.ws + WS_TOKE) + r * 4; const int* tp = (const int*)(P.ws + WS_TOKPOS) + r * 4; const float* tg = (const float*)(P.ws + WS_TOKGATE) + r * 4;
        const float* g2 = modv(P, DEPTH - 1, r, 5);
#pragma unroll
        for (int i = 0; i < 16; ++i) mo[i] = 0.f;
#pragma unroll
        for (int k = 0; k < 4; ++k) {
            const size_t row = (size_t)(s_off[te[k]] + tp[k]); const float g = tg[k];
#pragma unroll
            for (int i = 0; i < 4; ++i) { const u32x2 t = *(const u32x2*)(YB + row * D + 256 * i + 4 * lane);
                mo[4 * i] += g * bf2f((bf16_t)(t[0] & 0xffff)); mo[4 * i + 1] += g * bf2f((bf16_t)(t[0] >> 16)); mo[4 * i + 2] += g * bf2f((bf16_t)(t[1] & 0xffff)); mo[4 * i + 3] += g * bf2f((bf16_t)(t[1] >> 16)); }
        }
#pragma unroll
        for (int i = 0; i < 4; ++i) { const float4 t = *(const float4*)(g2 + 256 * i + 4 * lane); v[4 * i] += t.x * mo[4 * i]; v[4 * i + 1] += t.y * mo[4 * i + 1]; v[4 * i + 2] += t.z * mo[4 * i + 2]; v[4 * i + 3] += t.w * mo[4 * i + 3]; }
        float ss = 0.f;
#pragma unroll
        for (int i = 0; i < 16; ++i) ss += v[i] * v[i];
        ss = wave_sum(ss);
        const float rs = 1.f / sqrtf(ss * (1.f / D) + 1e-6f);
#pragma unroll
        for (int i = 0; i < 4; ++i) { const int c = 256 * i + 4 * lane; const float4 g = *(const float4*)(fg + c);
            *(float4*)(P.out + (size_t)(r - NT_CTX) * D + c) = make_float4(v[4 * i] * rs * g.x, v[4 * i + 1] * rs * g.y, v[4 * i + 2] * rs * g.z, v[4 * i + 3] * rs * g.w); }
    }
}

__device__ void phase_inproj_even(char* smem, const Params& P, int j, int bid, int nb) {
    bf16_t* Z = (bf16_t*)(P.ws + WS_Z); float* G = (float*)(P.ws + WS_GATES); const float* bin = P.in[I_EVBIN] + (size_t)j * P_EVEN;
    phase_gemm_dense(smem, (const bf16_t*)(P.ws + WS_A), D, (const bf16_t*)(P.ws + WS_WEVIN) + (size_t)j * P_EVEN_PAD * D, D, NT, P_EVEN_PAD, bid, nb,
        [&](f32x4 (&acc)[4][4], int wr, int wc, int fr, int fq, int row0, int col0) {
            epi_each(acc, wr, wc, fr, fq, [&](int r, int c, float v) {
                const int col = col0 + c, row = row0 + r;
                if (col < P_EVEN) { v += bin[col]; if (col >= 2048 && col < 2064) G[(size_t)row * 32 + col - 2048] = v; else Z[(size_t)row * ZLD + col] = f2bf(v); }
            });
        });
}
__device__ void phase_inproj_odd(char* smem, const Params& P, int j, int bid, int nb) {
    bf16_t* Z = (bf16_t*)(P.ws + WS_Z); float* G = (float*)(P.ws + WS_GATES);
    phase_gemm_dense(smem, (const bf16_t*)(P.ws + WS_A), D, (const bf16_t*)(P.ws + WS_WODIN) + (size_t)j * P_ODD_PAD * D, D, NT, P_ODD_PAD, bid, nb,
        [&](f32x4 (&acc)[4][4], int wr, int wc, int fr, int fq, int row0, int col0) {
            epi_each(acc, wr, wc, fr, fq, [&](int r, int c, float v) {
                const int col = col0 + c, row = row0 + r;
                if (col < 3072) Z[(size_t)row * ZLD + col] = f2bf(v); else if (col < P_ODD) G[(size_t)row * 32 + col - 3072] = v;
            });
        });
}
__device__ void phase_glu(char* smem, const Params& P, int j, int bid, int nb) {
    const bf16_t* YY = (const bf16_t*)(P.ws + WS_YY); bf16_t* CAT = (bf16_t*)(P.ws + WS_CAT); const float* gb = P.in[I_GLUB] + (size_t)j * 512;
    phase_gemm_dense(smem, YY, 512, (const bf16_t*)(P.ws + WS_WGLU) + (size_t)j * 512 * 512, 512, NT, 512, bid, nb,
        [&](f32x4 (&acc)[4][4], int wr, int wc, int fr, int fq, int row0, int col0) {
            epi_each(acc, wr, wc, fr, fq, [&](int r, int c, float v) {
                const int col = col0 + c, row = row0 + r; const float y = bf2f(YY[(size_t)row * 512 + col]);
                CAT[(size_t)row * D + 512 + col] = f2bf(y * sigmoidf_(v + gb[col]));
            });
        });
}
__device__ void phase_outproj(char* smem, const Params& P, int layer, const bf16_t* Wt, int bid, int nb) {
    float* H = (float*)(P.ws + WS_H);
    phase_gemm_dense(smem, (const bf16_t*)(P.ws + WS_CAT), D, Wt, D, NT, D, bid, nb,
        [&](f32x4 (&acc)[4][4], int wr, int wc, int fr, int fq, int row0, int col0) {
            epi_each(acc, wr, wc, fr, fq, [&](int r, int c, float v) {
                const int col = col0 + c, row = row0 + r; const float* g1 = modv(P, layer, row, 2);
                H[(size_t)row * D + col] += g1[col] * v;
            });
        });
}

constexpr int LDS_BYTES = 155648;
static_assert(GL_LDS_BYTES <= LDS_BYTES && S5_LDS_BYTES <= LDS_BYTES && ML_LDS_BYTES <= LDS_BYTES && GEMM_LDS + 256 <= LDS_BYTES, "LDS budget");
static_assert((BATCH + 1) * D * 4 + 8 * (BATCH + 1) * 64 * 4 <= LDS_BYTES, "modvec LDS");

#if MULTI_LAUNCH
#define KDEF(name, body) __global__ void __launch_bounds__(NTHREADS, 2) name(Params P, int a0, int a1) { SMEM_DECL; (void)a0; (void)a1; const int bid = blockIdx.x, nb = gridDim.x; body; }
KDEF(k_prologue, phase_prologue(smem, P, bid, nb))
KDEF(k_norm1, phase_norm1(smem, P, a0, bid, nb))
KDEF(k_inproj_even, phase_inproj_even(smem, P, a0, bid, nb))
KDEF(k_inproj_odd, phase_inproj_odd(smem, P, a0, bid, nb))
KDEF(k_conv, phase_conv(P, a0, bid, nb))
KDEF(k_mlstm, phase_mlstm(smem, P, bid, nb))
KDEF(k_s5, phase_s5(smem, P, a0, bid, nb))
KDEF(k_post_even, phase_post_even(P, a0, bid, nb))
KDEF(k_glu, phase_glu(smem, P, a0, bid, nb))
KDEF(k_outproj_even, phase_outproj(smem, P, a0, (const bf16_t*)(P.ws + WS_WEVOUT) + (size_t)a1 * D * D, bid, nb))
KDEF(k_outproj_odd, phase_outproj(smem, P, a0, (const bf16_t*)(P.ws + WS_WODOUT) + (size_t)a1 * D * D, bid, nb))
KDEF(k_gla, phase_gla(smem, P, a0, bid, nb))
KDEF(k_post_odd, phase_post_odd(P, a0, bid, nb))
KDEF(k_norm2_router, phase_norm2_router(smem, P, a0, bid, nb))
KDEF(k_moe_gu, phase_moe_gu(smem, P, a0, bid, nb))
KDEF(k_moe_down, phase_moe_down(smem, P, a0, bid, nb))
KDEF(k_final, phase_final(smem, P, bid, nb))
#endif

#ifdef HOST_EMU
#ifndef EMU_GRID
#define EMU_GRID 16
#endif
static const int kGrid = EMU_GRID;
int g_stop_after = 1000;
void emu_hook(int step, const char* name, const Params& p);
#define RUN(k, a0, a1) do { if (step < g_stop_after) { LAUNCH(k, kGrid, NTHREADS, LDS_BYTES, stream, p, a0, a1); emu_hook(step, #k, p); } ++step; } while (0)
#else
static const int kGrid = 256;
#define RUN(k, a0, a1) do { ++step; LAUNCH(k, kGrid, NTHREADS, LDS_BYTES, stream, p, a0, a1); } while (0)
#endif

extern "C" void kernel_launch(void* const* d_in, const int* in_sizes, int n_in, void* d_out, int out_size, void* d_ws, size_t ws_size, hipStream_t stream) {
    (void)in_sizes; (void)n_in; (void)out_size;
    if (ws_size < WS_TOTAL) { fprintf(stderr, "kernel_launch: workspace too small (%zu < %zu)\n", ws_size, (size_t)WS_TOTAL); return; }
    Params p{};
    for (int i = 0; i < N_INPUTS; ++i) p.in[i] = (const float*)d_in[i];
    p.out = (float*)d_out; p.ws = (char*)d_ws;
    hipMemsetAsync(d_ws, 0, WS_ZERO_BYTES, stream);
    int step = 0;
#if MULTI_LAUNCH
#ifndef HOST_EMU
    static bool attr_done = false;
    if (!attr_done) {
        attr_done = true;
        const void* ks[] = {(const void*)k_prologue, (const void*)k_norm1, (const void*)k_inproj_even, (const void*)k_inproj_odd, (const void*)k_conv, (const void*)k_mlstm, (const void*)k_s5,
                            (const void*)k_post_even, (const void*)k_glu, (const void*)k_outproj_even, (const void*)k_outproj_odd, (const void*)k_gla, (const void*)k_post_odd,
                            (const void*)k_norm2_router, (const void*)k_moe_gu, (const void*)k_moe_down, (const void*)k_final};
        for (const void* k : ks) if (hipFuncSetAttribute(k, hipFuncAttributeMaxDynamicSharedMemorySize, LDS_BYTES) != hipSuccess) fprintf(stderr, "kernel_launch: hipFuncSetAttribute failed\n");
    }
#endif
    RUN(k_prologue, 0, 0);
    for (int layer = 0; layer < DEPTH; ++layer) {
        const int j = layer / 2;
        RUN(k_norm1, layer, 0);
        if ((layer & 1) == 0) {
            RUN(k_inproj_even, j, 0);
            RUN(k_conv, j, 0);
            RUN(k_mlstm, 0, 0);
            RUN(k_s5, j, 0);
            RUN(k_post_even, j, 0);
            RUN(k_glu, j, 0);
            RUN(k_outproj_even, layer, j);
        } else {
            RUN(k_inproj_odd, j, 0);
            RUN(k_gla, j, 0);
            RUN(k_post_odd, j, 0);
            RUN(k_outproj_odd, layer, j);
        }
        RUN(k_norm2_router, layer, 0);
        RUN(k_moe_gu, layer, 0);
        RUN(k_moe_down, layer, 0);
    }
    RUN(k_final, 0, 0);
#endif
}
```

```cpp
#ifndef HOST_EMU
#include <hip/hip_runtime.h>
#endif
#include <cstdio>
#include <cstdint>

#ifndef CFG_B
#define CFG_B 16
#endif
#ifndef CFG_SEQ
#define CFG_SEQ 2048
#endif
#ifndef CFG_CTX
#define CFG_CTX 256
#endif
#ifndef CFG_DEPTH
#define CFG_DEPTH 4
#endif
#ifndef CFG_NE
#define CFG_NE 32
#endif
#ifdef HOST_EMU
#undef MULTI_LAUNCH
#define MULTI_LAUNCH 1
#endif
#ifndef MULTI_LAUNCH
#define MULTI_LAUNCH 0
#endif

constexpr int D = 1024, BATCH = CFG_B, SEQ = CFG_SEQ, CTXL = CFG_CTX, DEPTH = CFG_DEPTH, NE = CFG_NE, TOPK = 4;
constexpr int N_EVEN = (DEPTH + 1) / 2, N_ODD = DEPTH / 2;
constexpr int NT_CTX = BATCH * CTXL, NT_LAT = BATCH * SEQ, NT = NT_CTX + NT_LAT;
constexpr int GRID_W = 64, GROWS = SEQ / GRID_W;
constexpr int P_EVEN = 2576, P_EVEN_PAD = 2816, P_ODD = 3104, P_ODD_PAD = 3328, ZLD = 3200;
constexpr int NCH_CTX = CTXL / 64, NCH_LAT = SEQ / 64, NCH = NCH_CTX + NCH_LAT;
constexpr int MOE_BM = 256;
constexpr int ROWS_MAX = NT * TOPK + NE * MOE_BM;
constexpr int NTHREADS = 512;
static_assert(NT % 256 == 0, "token count must be a multiple of 256");
static_assert(SEQ % 64 == 0 && CTXL % 64 == 0, "chunking");

typedef unsigned short bf16_t;
#ifndef HOST_EMU
typedef short bf16x8 __attribute__((ext_vector_type(8)));
typedef float f32x4 __attribute__((ext_vector_type(4)));
typedef float f32x16 __attribute__((ext_vector_type(16)));
#endif
typedef unsigned u32x4 __attribute__((ext_vector_type(4)));
typedef unsigned u32x2 __attribute__((ext_vector_type(2)));
typedef int i32x4 __attribute__((ext_vector_type(4)));
typedef int i32x8 __attribute__((ext_vector_type(8)));

#ifdef HOST_EMU
#define MFMA16(a, b, c) emu_mfma_16x16x32_bf16(a, b, c)
#define MFMA32(a, b, c) emu_mfma_32x32x16_bf16(a, b, c)
#define MFMA128F8(a, b, c) emu_mfma_16x16x128_fp8(a, b, c)
#define GLDS16(g, l) emu_glds16((const void*)(g), (void*)(l))
#define GLDS4(g, l) emu_glds4((const void*)(g), (void*)(l))
#define WAIT_VM0() do {} while (0)
#define SMEM_DECL char* smem = emu::g_smem
#define LAUNCH(kern, grid, block, lds, stream, ...) emu::launch(grid, block, lds, [=]() { kern(__VA_ARGS__); })
#else
#define LDSAS __attribute__((address_space(3)))
#define MFMA16(a, b, c) __builtin_amdgcn_mfma_f32_16x16x32_bf16(a, b, c, 0, 0, 0)
#define MFMA32(a, b, c) __builtin_amdgcn_mfma_f32_32x32x16_bf16(a, b, c, 0, 0, 0)
#define MFMA128F8(a, b, c) __builtin_amdgcn_mfma_scale_f32_16x16x128_f8f6f4(a, b, c, 0, 0, 0, 0, 0, 0)
#define GLDS16(g, l) __builtin_amdgcn_global_load_lds((const unsigned*)(g), (LDSAS unsigned*)(l), 16, 0, 0)
#define GLDS4(g, l) __builtin_amdgcn_global_load_lds((const unsigned*)(g), (LDSAS unsigned*)(l), 4, 0, 0)
#define WAIT_VM0() asm volatile("s_waitcnt vmcnt(0)" ::: "memory")
#define SMEM_DECL extern __shared__ __attribute__((aligned(256))) char smem[]
#define LAUNCH(kern, grid, block, lds, stream, ...) hipLaunchKernelGGL(kern, dim3(grid), dim3(block), lds, stream, __VA_ARGS__)
#endif

#ifdef HOST_EMU
__device__ __forceinline__ int tidx(int wv) { (void)wv; return (int)threadIdx.x; }
#else
__device__ __forceinline__ int tidx(int wv) { int l; asm volatile("v_mbcnt_lo_u32_b32 %0, -1, 0\n\tv_mbcnt_hi_u32_b32 %0, -1, %0" : "=v"(l)); return (wv << 6) | l; }
#endif
#ifdef HOST_EMU
__device__ __forceinline__ int uni(int v) { return v; }
#else
__device__ __forceinline__ int uni(int v) { return __builtin_amdgcn_readfirstlane(v); }
#endif
__device__ __forceinline__ float bf2f(bf16_t v) { unsigned u = ((unsigned)v) << 16; return __builtin_bit_cast(float, u); }
#ifdef HOST_EMU
__device__ __forceinline__ bf16_t f2bf(float f) { unsigned u = __builtin_bit_cast(unsigned, f); u += 0x7fffu + ((u >> 16) & 1u); return (bf16_t)(u >> 16); }
#else
__device__ __forceinline__ bf16_t f2bf(float f) { return __builtin_bit_cast(unsigned short, (__bf16)f); }
#endif
#ifdef HOST_EMU
__device__ __forceinline__ unsigned pack2bf(float lo, float hi) { return (unsigned)f2bf(lo) | ((unsigned)f2bf(hi) << 16); }
#else
typedef __bf16 hwbf16x2 __attribute__((ext_vector_type(2)));
__device__ __forceinline__ unsigned pack2bf(float lo, float hi) { const hwbf16x2 v = {(__bf16)lo, (__bf16)hi}; return __builtin_bit_cast(unsigned, v); }
#endif
#ifdef HOST_EMU
__device__ __forceinline__ unsigned pack4f8(float a, float b, float c, float d) { return (unsigned)emu_f2fp8(a) | ((unsigned)emu_f2fp8(b) << 8) | ((unsigned)emu_f2fp8(c) << 16) | ((unsigned)emu_f2fp8(d) << 24); }
#else
__device__ __forceinline__ float clampf8(float x) { return fminf(fmaxf(x, -448.f), 448.f); }
__device__ __forceinline__ unsigned pack4f8(float a, float b, float c, float d) { int v = __builtin_amdgcn_cvt_pk_fp8_f32(clampf8(a), clampf8(b), 0, false); v = __builtin_amdgcn_cvt_pk_fp8_f32(clampf8(c), clampf8(d), v, true); return (unsigned)v; }
#endif
constexpr float F8_SA = 4.f, F8_SW = 32.f, F8_SH = 8.f, F8_SY = 16.f;
#ifdef HOST_EMU
__device__ __forceinline__ void unpack4f8(unsigned v, float (&o)[4]) { for (int i = 0; i < 4; ++i) o[i] = emu_fp82f((unsigned char)(v >> (8 * i))); }
#else
typedef float f32x2 __attribute__((ext_vector_type(2)));
__device__ __forceinline__ void unpack4f8(unsigned v, float (&o)[4]) { const f32x2 lo = __builtin_amdgcn_cvt_pk_f32_fp8((int)v, false), hi = __builtin_amdgcn_cvt_pk_f32_fp8((int)v, true); o[0] = lo[0]; o[1] = lo[1]; o[2] = hi[0]; o[3] = hi[1]; }
#endif
#ifdef HOST_EMU
__device__ __forceinline__ float rcpf_(float x) { return 1.f / x; }
__device__ __forceinline__ float rsqf_(float x) { return 1.f / sqrtf(x); }
#else
__device__ __forceinline__ float rcpf_(float x) { return __builtin_amdgcn_rcpf(x); }
__device__ __forceinline__ float rsqf_(float x) { return __builtin_amdgcn_rsqf(x); }
#endif
__device__ __forceinline__ float sigmoidf_(float x) { return rcpf_(1.f + __expf(-x)); }
__device__ __forceinline__ float siluf_(float x) { return x * rcpf_(1.f + __expf(-x)); }
__device__ __forceinline__ float logsigmoidf_(float x) { return fminf(x, 0.f) - log1pf(__expf(-fabsf(x))); }
__device__ __forceinline__ float logsigmoid_fast(float x) { return fminf(x, 0.f) - __logf(1.f + __expf(-fabsf(x))); }
__device__ __forceinline__ float gelu_tanhf_(float x) { float u = 0.7978845608028654f * (x + 0.044715f * x * x * x); float t = 1.f - 2.f * rcpf_(1.f + __expf(2.f * u)); return 0.5f * x * (1.f + t); }
#ifdef HOST_EMU
__device__ __forceinline__ float shx(float v, int m, int lane) { (void)lane; return __shfl_xor(v, m); }
__device__ __forceinline__ int shx(int v, int m, int lane) { (void)lane; return __shfl_xor(v, m); }
__device__ __forceinline__ float shfl_from(float v, int src, int lane) { (void)lane; return __shfl(v, src); }
#else
__device__ __forceinline__ float shx(float v, int m, int lane) { return __builtin_bit_cast(float, __builtin_amdgcn_ds_bpermute((lane ^ m) << 2, __builtin_bit_cast(int, v))); }
__device__ __forceinline__ int shx(int v, int m, int lane) { return __builtin_amdgcn_ds_bpermute((lane ^ m) << 2, v); }
__device__ __forceinline__ float shfl_from(float v, int src, int lane) { (void)lane; return __builtin_bit_cast(float, __builtin_amdgcn_ds_bpermute(src << 2, __builtin_bit_cast(int, v))); }
#endif
__device__ __forceinline__ float wave_sum(float v, int lane) { for (int m = 32; m >= 1; m >>= 1) v += shx(v, m, lane); return v; }
__device__ __forceinline__ float group16_sum(float v, int lane) { for (int m = 8; m >= 1; m >>= 1) v += shx(v, m, lane); return v; }

enum { I_X = 0, I_C, I_CTX, I_CCTX, I_MODW, I_MODB, I_NMIXG, I_NFFNG, I_EVWIN, I_EVBIN, I_EVCONVW, I_EVCONVB, I_EVMNORM,
       I_AREF, I_AIMF, I_LDTF, I_AREB, I_AIMB, I_LDTB, I_S5BRE, I_S5BIM, I_S5CRE, I_S5CIM, I_S5D, I_GLUW, I_GLUB, I_EVWOUT,
       I_ODWIN, I_ODW2F, I_ODB2F, I_ODW2B, I_ODB2B, I_ODNORM, I_ODWOUT, I_RW, I_RB, I_WGU, I_BGU, I_WDN, I_BDN, I_FNORM, N_INPUTS };

struct Params { const float* in[N_INPUTS]; float* out; char* ws; };

constexpr size_t al256(size_t x) { return (x + 255) & ~(size_t)255; }
constexpr int XCD_BAR_WORDS_C = 3456;
constexpr size_t WS_BAR = 0;
constexpr int N_BAR_SLOTS = 4;
constexpr size_t WS_CNT = WS_BAR + (size_t)N_BAR_SLOTS * XCD_BAR_WORDS_C * 4;
constexpr size_t WS_ZERO_BYTES = al256(WS_CNT + (size_t)DEPTH * NE * 4);
constexpr size_t WS_MODV = WS_ZERO_BYTES;
constexpr size_t WS_H = al256(WS_MODV + (size_t)DEPTH * (BATCH + 1) * 6 * D * 4);
constexpr size_t WS_A = al256(WS_H + (size_t)NT * D * 4);
constexpr size_t WS_CAT = al256(WS_A + (size_t)NT * D * 2);
constexpr size_t WS_Z = al256(WS_CAT + (size_t)NT * D * 2);
constexpr size_t WS_GATES = al256(WS_Z + (size_t)NT * ZLD * 2);
constexpr size_t WS_QK = al256(WS_GATES + (size_t)NT * 32 * 4);
constexpr size_t WS_MO = al256(WS_QK + (size_t)NT * D * 2);
constexpr size_t WS_YY = al256(WS_MO + (size_t)2 * NT * D * 4);
constexpr size_t WS_TOKE = al256(WS_YY + (size_t)NT * 512 * 2);
constexpr size_t WS_TOKPOS = al256(WS_TOKE + (size_t)NT * 4 * 4);
constexpr size_t WS_TOKGATE = al256(WS_TOKPOS + (size_t)NT * 4 * 4);
constexpr size_t WS_ROWTOK = al256(WS_TOKGATE + (size_t)NT * 4 * 4);
constexpr size_t WS_HDN = al256(WS_ROWTOK + (size_t)NE * NT * 4);
constexpr size_t WS_YB = al256(WS_HDN + (size_t)ROWS_MAX * D * 2);
constexpr size_t WS_WEVIN = al256(WS_YB + (size_t)ROWS_MAX * D * 2);
constexpr size_t WS_WODIN = al256(WS_WEVIN + (size_t)N_EVEN * P_EVEN_PAD * D * 2);
constexpr size_t WS_WEVOUT = al256(WS_WODIN + (size_t)N_ODD * P_ODD_PAD * D * 2);
constexpr size_t WS_WGLU = al256(WS_WEVOUT + (size_t)N_EVEN * D * D * 2);
constexpr size_t WS_WODOUT = al256(WS_WGLU + (size_t)N_EVEN * 512 * 512 * 2);
constexpr size_t WS_WGU = al256(WS_WODOUT + (size_t)N_ODD * D * D * 2);
constexpr size_t WS_WDN = al256(WS_WGU + (size_t)DEPTH * NE * 2 * D * D * 2);
constexpr size_t WS_S5AB = al256(WS_WDN + (size_t)DEPTH * NE * D * D * 2);
constexpr size_t WS_S5CZ = al256(WS_S5AB + (size_t)N_EVEN * 64 * 128 * 4);
constexpr size_t WS_S5BT = al256(WS_S5CZ + (size_t)N_EVEN * 64 * 16 * 128 * 2);
constexpr size_t WS_RWT = al256(WS_S5BT + (size_t)N_EVEN * 32 * 128 * 16 * 2);
constexpr int GI_Q = 0, GI_KD = 16384, GI_P = 32768, GI_VT = 40960, GI_DEC = 73728, GI_BYTES = 74240;
constexpr size_t WS_GIMG = al256(WS_RWT + (size_t)DEPTH * NE * D * 4);
constexpr size_t WS_TOTAL = al256(WS_GIMG + (size_t)BATCH * 2 * NCH * 4 * GI_BYTES);

__device__ __forceinline__ int mod_row(int r) { return r < NT_CTX ? BATCH : (r - NT_CTX) / SEQ; }
__device__ __forceinline__ const float* modv(const Params& P, int layer, int r, int part) { return (const float*)(P.ws + WS_MODV) + ((size_t)(layer * (BATCH + 1) + mod_row(r)) * 6 + part) * D; }

constexpr int GEMM_STAGE = 32768 + 16384, GEMM_LDS = 3 * GEMM_STAGE;
#ifdef HOST_EMU
#define WAIT_VM6() do {} while (0)
#define RAW_BARRIER() __syncthreads()
#else
#define WAIT_VM6() asm volatile("s_waitcnt vmcnt(6)" ::: "memory")
#define RAW_BARRIER() do { __builtin_amdgcn_s_barrier(); asm volatile("" ::: "memory"); } while (0)
#endif
template <class ARow, class Epi>
__device__ __forceinline__ void gemm_tile(int wv, char* smem, ARow arow, const bf16_t* Bt, int ldb, int K, Epi epi) {
    const int tid = tidx(wv), wid = tid >> 6, lane = tid & 63, wr = wid >> 1, wc = wid & 1, fr = lane & 15, fq = lane >> 4;
    const char* ap[4]; const char* bp[2];
#pragma unroll
    for (int i = 0; i < 4; ++i) { const int id = tid + i * 512, row = id >> 3, c = (id & 7) ^ (row & 7); ap[i] = (const char*)arow(row) + c * 16; }
#pragma unroll
    for (int i = 0; i < 2; ++i) { const int id = tid + i * 512, row = id >> 3, c = (id & 7) ^ (row & 7); bp[i] = (const char*)(Bt + (size_t)row * ldb) + c * 16; }
    f32x4 acc[4][4];
#pragma unroll
    for (int m = 0; m < 4; ++m)
#pragma unroll
        for (int n = 0; n < 4; ++n) acc[m][n] = f32x4{0.f, 0.f, 0.f, 0.f};
    const int nt = K / 64;
    auto stage = [&](int t, int buf) {
        char* sa = smem + buf * GEMM_STAGE; char* sb = sa + 32768;
#pragma unroll
        for (int i = 0; i < 4; ++i) GLDS16(ap[i] + (size_t)t * 128, sa + (tid + i * 512) * 16);
#pragma unroll
        for (int i = 0; i < 2; ++i) GLDS16(bp[i] + (size_t)t * 128, sb + (tid + i * 512) * 16);
    };
    WAIT_VM0();
    stage(0, 0);
    stage(1, 1);
    int cur = 0;
    for (int t = 0; t < nt; ++t) {
        if (t + 1 < nt) WAIT_VM6(); else WAIT_VM0();
        RAW_BARRIER();
        if (t + 2 < nt) stage(t + 2, cur >= 1 ? cur - 1 : 2);
        const char* sa = smem + cur * GEMM_STAGE; const char* sb = sa + 32768;
#pragma unroll
        for (int kk = 0; kk < 2; ++kk) {
            bf16x8 af[4], bfr[4];
#pragma unroll
            for (int m = 0; m < 4; ++m) { const int row = wr * 64 + m * 16 + fr; af[m] = *(const bf16x8*)(sa + row * 128 + (((kk * 4 + fq) ^ (row & 7)) << 4)); }
#pragma unroll
            for (int n = 0; n < 4; ++n) { const int row = wc * 64 + n * 16 + fr; bfr[n] = *(const bf16x8*)(sb + row * 128 + (((kk * 4 + fq) ^ (row & 7)) << 4)); }
#pragma unroll
            for (int m = 0; m < 4; ++m)
#pragma unroll
                for (int n = 0; n < 4; ++n) acc[m][n] = MFMA16(af[m], bfr[n], acc[m][n]);
        }
        cur = cur == 2 ? 0 : cur + 1;
    }
    epi(acc, wr, wc, fr, fq);
    __syncthreads();
}
constexpr int G2_HT = 128 * 64;
constexpr int GEMM2_LDS = 8 * G2_HT * 2;
#ifdef HOST_EMU
#define G2_WAIT_V(n) do {} while (0)
#define G2_WAIT_L(n) do {} while (0)
#define G2_BAR __syncthreads()
#define G2_SCHED do {} while (0)
#define G2_PRIO(x) do {} while (0)
#else
#define G2_WAIT_V(n) asm volatile("s_waitcnt vmcnt(" #n ")" ::: "memory")
#define G2_WAIT_L(n) asm volatile("s_waitcnt lgkmcnt(" #n ")" ::: "memory")
#define G2_BAR __builtin_amdgcn_s_barrier()
#define G2_SCHED __builtin_amdgcn_sched_barrier(0)
#define G2_PRIO(x) __builtin_amdgcn_s_setprio(x)
#endif
__device__ __forceinline__ int g2_lds_byte(int r, int c) { const int st = (r >> 4) * 2 + (c >> 5), rr = r & 15, cc = c & 31, ob = rr * 64 + cc * 2; return st * 1024 + (ob ^ (((ob >> 9) & 1) << 5)); }
__device__ __forceinline__ void g2_stage_rc(int b, int& R, int& C) { const int st = b / 1024, sb = b % 1024, swz = sb ^ (((sb >> 9) & 1) << 5); R = (st >> 1) * 16 + swz / 64; C = (st & 1) * 32 + (swz % 64) / 2; }
struct G2NoPre { __device__ __forceinline__ void operator()() const {} };
template <bool F8 = false, class ARow, class Epi, class Pre = G2NoPre>
__device__ __forceinline__ void gemm_tile256(int wv, char* smem, const bf16_t* Abase, ARow arow  , const bf16_t* Bt, int ldb, int K, Epi epi, Pre pre = Pre()) {
    bf16_t* shm = (bf16_t*)smem;
#define G2_SA(b, h) (shm + ((b) * 2 + (h)) * G2_HT)
#define G2_SB(b, h) (shm + (4 + (b) * 2 + (h)) * G2_HT)
    const int tid = tidx(wv), wid = tid >> 6, lane = tid & 63, wr = wid >> 2, wc = wid & 3, fr = lane & 15, fq = lane >> 4;
    unsigned pa[2][2], pb;
    {
        int R, C;
        g2_stage_rc(tid * 16, R, C);
        pa[0][0] = arow(R) + (unsigned)C; pa[0][1] = arow(R + 64) + (unsigned)C; pa[1][0] = arow(128 + R) + (unsigned)C; pa[1][1] = arow(192 + R) + (unsigned)C; pb = (unsigned)(R * ldb + C);
    }
    const size_t bhalf = (size_t)128 * ldb;
#define G2_CAT8(x, y) __builtin_shufflevector(x, y, 0, 1, 2, 3, 4, 5, 6, 7)
#define G2_STAGE_A(Pp, h, kt) do { _Pragma("unroll") for (int _i = 0; _i < 2; ++_i) GLDS16(Abase + pa[h][_i] + (kt) * 64, (char*)(Pp) + tid * 16 + _i * 8192); } while (0)
#define G2_STAGE_B(Pp, h, kt) do { _Pragma("unroll") for (int _i = 0; _i < 2; ++_i) GLDS16(Bt + (h) * bhalf + (size_t)(_i * 64) * ldb + pb + (kt) * 64, (char*)(Pp) + tid * 16 + _i * 8192); } while (0)
#define G2_LDA(dst, b, h) do { _Pragma("unroll") for (int m = 0; m < 4; ++m) { const i32x4 _lo = *(const i32x4*)((const char*)G2_SA(b, h) + g2_lds_byte(wr * 64 + m * 16 + fr, fq * 8)), _hi = *(const i32x4*)((const char*)G2_SA(b, h) + g2_lds_byte(wr * 64 + m * 16 + fr, 32 + fq * 8)); dst[m] = G2_CAT8(_lo, _hi); } } while (0)
#define G2_LDB(dst, b, h) do { _Pragma("unroll") for (int n = 0; n < 2; ++n) { const i32x4 _lo = *(const i32x4*)((const char*)G2_SB(b, h) + g2_lds_byte(wc * 32 + n * 16 + fr, fq * 8)), _hi = *(const i32x4*)((const char*)G2_SB(b, h) + g2_lds_byte(wc * 32 + n * 16 + fr, 32 + fq * 8)); dst[n] = G2_CAT8(_lo, _hi); } } while (0)
#define G2_LO(x) __builtin_bit_cast(bf16x8, __builtin_shufflevector(x, x, 0, 1, 2, 3))
#define G2_HI(x) __builtin_bit_cast(bf16x8, __builtin_shufflevector(x, x, 4, 5, 6, 7))
#define G2_MMA(ai, bj, Af, Bf) do { G2_PRIO(1); _Pragma("unroll") for (int m = 0; m < 4; ++m) _Pragma("unroll") for (int n = 0; n < 2; ++n) { \
        if (F8) acc[ai][bj][m][n] = MFMA128F8(Bf[n], Af[m], acc[ai][bj][m][n]); \
        else { acc[ai][bj][m][n] = MFMA16(G2_LO(Bf[n]), G2_LO(Af[m]), acc[ai][bj][m][n]); acc[ai][bj][m][n] = MFMA16(G2_HI(Bf[n]), G2_HI(Af[m]), acc[ai][bj][m][n]); } } G2_PRIO(0); } while (0)
    f32x4 acc[2][2][4][2];
#pragma unroll
    for (int a = 0; a < 2; ++a)
#pragma unroll
        for (int b = 0; b < 2; ++b)
#pragma unroll
            for (int m = 0; m < 4; ++m)
#pragma unroll
                for (int n = 0; n < 2; ++n) acc[a][b][m][n] = f32x4{0.f, 0.f, 0.f, 0.f};
    i32x8 At[4], B0[2], B1[2];
    const int nt = K / 64;
    G2_WAIT_V(0);
    pre(); G2_SCHED;
    G2_STAGE_B(G2_SB(0, 0), 0, 0); G2_STAGE_A(G2_SA(0, 0), 0, 0); G2_STAGE_B(G2_SB(0, 1), 1, 0); G2_STAGE_A(G2_SA(0, 1), 1, 0);
    if (wr == 1) G2_BAR;
    G2_WAIT_V(4); G2_BAR;
    G2_STAGE_B(G2_SB(1, 0), 0, 1); G2_STAGE_A(G2_SA(1, 0), 0, 1); G2_STAGE_B(G2_SB(1, 1), 1, 1);
    G2_WAIT_V(6); G2_BAR;
    for (int t = 0; t < nt - 2; t += 2) {
        G2_LDB(B0, 0, 0); G2_SCHED; G2_LDA(At, 0, 0); G2_STAGE_A(G2_SA(1, 1), 1, t + 1);
        G2_WAIT_L(8); G2_BAR; G2_WAIT_L(0); G2_MMA(0, 0, At, B0); G2_BAR; G2_SCHED;
        G2_LDB(B1, 0, 1); G2_STAGE_B(G2_SB(0, 0), 0, t + 2);
        G2_BAR; G2_WAIT_L(0); G2_MMA(0, 1, At, B1); G2_BAR;
        G2_LDA(At, 0, 1); G2_STAGE_A(G2_SA(0, 0), 0, t + 2);
        G2_BAR; G2_WAIT_L(0); G2_MMA(1, 0, At, B0); G2_BAR; G2_SCHED;
        G2_STAGE_B(G2_SB(0, 1), 1, t + 2);
        G2_WAIT_V(6); G2_BAR; G2_MMA(1, 1, At, B1); G2_BAR;
        G2_LDB(B0, 1, 0); G2_SCHED; G2_LDA(At, 1, 0); G2_STAGE_A(G2_SA(0, 1), 1, t + 2);
        G2_WAIT_L(8); G2_BAR; G2_WAIT_L(0); G2_MMA(0, 0, At, B0); G2_BAR; G2_SCHED;
        G2_LDB(B1, 1, 1); G2_STAGE_B(G2_SB(1, 0), 0, t + 3);
        G2_BAR; G2_WAIT_L(0); G2_MMA(0, 1, At, B1); G2_BAR;
        G2_LDA(At, 1, 1); G2_STAGE_A(G2_SA(1, 0), 0, t + 3);
        G2_BAR; G2_WAIT_L(0); G2_MMA(1, 0, At, B0); G2_BAR; G2_SCHED;
        G2_STAGE_B(G2_SB(1, 1), 1, t + 3);
        G2_WAIT_V(6); G2_BAR; G2_MMA(1, 1, At, B1); G2_BAR;
    }
    { G2_LDB(B0, 0, 0); G2_WAIT_V(0); G2_LDA(At, 0, 0); G2_STAGE_A(G2_SA(1, 1), 1, nt - 1);
      G2_BAR; G2_WAIT_L(0); G2_MMA(0, 0, At, B0); G2_BAR;
      G2_LDB(B1, 0, 1); G2_BAR; G2_WAIT_L(0); G2_MMA(0, 1, At, B1); G2_BAR;
      G2_LDA(At, 0, 1); G2_WAIT_V(4); G2_BAR; G2_WAIT_L(0); G2_MMA(1, 0, At, B0); G2_MMA(1, 1, At, B1); G2_BAR; }
    { G2_LDB(B0, 1, 0); G2_LDA(At, 1, 0); G2_WAIT_V(2); G2_BAR; G2_WAIT_L(0); G2_MMA(0, 0, At, B0); G2_BAR;
      G2_LDB(B1, 1, 1); G2_WAIT_V(0); G2_BAR; G2_WAIT_L(0); G2_MMA(0, 1, At, B1); G2_BAR;
      G2_LDA(At, 1, 1); G2_BAR; G2_WAIT_L(0); G2_MMA(1, 0, At, B0); G2_MMA(1, 1, At, B1); G2_BAR; }
    if (wr == 0) G2_BAR;
    { const int t2 = tidx(wv), w2 = t2 >> 6, l2 = t2 & 63; epi(acc, w2 >> 2, w2 & 3, l2 & 15, l2 >> 4); }
    __syncthreads();
}
template <class F> __device__ __forceinline__ void epi256_vec4(f32x4 (&acc)[2][2][4][2], int wr, int wc, int fr, int fq, F f) {
#pragma unroll
    for (int ai = 0; ai < 2; ++ai)
#pragma unroll
        for (int bj = 0; bj < 2; ++bj)
#pragma unroll
            for (int m = 0; m < 4; ++m)
#pragma unroll
                for (int n = 0; n < 2; ++n) f(ai * 128 + wr * 64 + m * 16 + fr, bj * 128 + wc * 32 + n * 16 + fq * 4, acc[ai][bj][m][n]);
}

template <class F> __device__ __forceinline__ void epi_each(f32x4 (&acc)[4][4], int wr, int wc, int fr, int fq, F f) {
#pragma unroll
    for (int m = 0; m < 4; ++m)
#pragma unroll
        for (int n = 0; n < 4; ++n)
#pragma unroll
            for (int j = 0; j < 4; ++j) f(wr * 64 + m * 16 + fq * 4 + j, wc * 64 + n * 16 + fr, acc[m][n][j]);
}

struct TJob { const float* src; bf16_t* dst; int K, N, Npad, nmat, perm, f8; };
__device__ __forceinline__ void transpose_tile(int wv, char* smem, const TJob& J, int mat, int kt, int ntile) {
    float* s = (float*)smem;
    const float* src = J.src + (size_t)mat * J.K * J.N;
    bf16_t* dst = J.dst + (size_t)mat * J.Npad * J.K;
    const int tid = tidx(wv);
    float4 v[8];
#pragma unroll
    for (int i = 0; i < 8; ++i) { const int e = tid + i * 512, kr = e >> 6, n = ntile * 256 + (e & 63) * 4; v[i] = (n < J.N) ? *(const float4*)(src + (size_t)(kt * 64 + kr) * J.N + n) : make_float4(0.f, 0.f, 0.f, 0.f); }
#pragma unroll
    for (int i = 0; i < 8; ++i) { const int e = tid + i * 512, kr = e >> 6, nc = (e & 63) * 4; float* d = s + kr * 257 + nc; d[0] = v[i].x; d[1] = v[i].y; d[2] = v[i].z; d[3] = v[i].w; }
    __syncthreads();
#pragma unroll
    for (int i = 0; i < 4; ++i) {
        const int e = tid + i * 512, nr = e >> 3, k0 = (e & 7) * 8;
        int srcc = nr;
        if (J.perm) { const int blk = nr & ~31, w = nr & 31; srcc = blk | ((w & 15) << 1) | (w >> 4); }
        const float* c = s + k0 * 257 + srcc;
        if (J.f8) {
            unsigned char* d8 = (unsigned char*)J.dst + ((size_t)mat * J.Npad + ntile * 256 + nr) * J.K + kt * 64 + k0;
            *(u32x2*)d8 = u32x2{pack4f8(c[0] * F8_SW, c[257] * F8_SW, c[2 * 257] * F8_SW, c[3 * 257] * F8_SW), pack4f8(c[4 * 257] * F8_SW, c[5 * 257] * F8_SW, c[6 * 257] * F8_SW, c[7 * 257] * F8_SW)};
        } else {
        const u32x4 o = u32x4{pack2bf(c[0], c[257]), pack2bf(c[2 * 257], c[3 * 257]), pack2bf(c[4 * 257], c[5 * 257]), pack2bf(c[6 * 257], c[7 * 257])};
        if (ntile * 256 + nr < J.Npad) *(u32x4*)(dst + (size_t)(ntile * 256 + nr) * J.K + kt * 64 + k0) = o;
        }
    }
    __syncthreads();
}
__device__ __forceinline__ void modvec_item(int wv, char* smem, const Params& P, int item) {
    float* sc = (float*)smem;
    float* red = sc + (BATCH + 1) * D;
    const int tid = tidx(wv), layer = item / (6 * D / 64), col0 = (item % (6 * D / 64)) * 64;
    for (int e = tid; e < (BATCH + 1) * D; e += NTHREADS) { const int b = e / D, k = e % D; const float v = (b < BATCH) ? P.in[I_C][b * D + k] : P.in[I_CCTX][k]; sc[e] = siluf_(v); }
    __syncthreads();
    const int cl = tid & 63, ks = tid >> 6;
    float acc[BATCH + 1];
#pragma unroll
    for (int b = 0; b <= BATCH; ++b) acc[b] = 0.f;
    const float* W = P.in[I_MODW] + (size_t)layer * D * 6 * D + col0 + cl;
    for (int k = ks * 128; k < ks * 128 + 128; ++k) {
        const float w = W[(size_t)k * 6 * D];
#pragma unroll
        for (int b = 0; b <= BATCH; ++b) acc[b] += sc[b * D + k] * w;
    }
#pragma unroll
    for (int b = 0; b <= BATCH; ++b) red[(ks * (BATCH + 1) + b) * 64 + cl] = acc[b];
    __syncthreads();
    for (int e = tid; e < (BATCH + 1) * 64; e += NTHREADS) {
        const int b = e >> 6, c = e & 63; float s = 0.f;
#pragma unroll
        for (int q = 0; q < 8; ++q) s += red[(q * (BATCH + 1) + b) * 64 + c];
        ((float*)(P.ws + WS_MODV))[((size_t)layer * (BATCH + 1) + b) * 6 * D + col0 + c] = s + P.in[I_MODB][layer * 6 * D + col0 + c];
    }
    __syncthreads();
}
__device__ __forceinline__ void s5_tables_item(int wv, const Params& P, int item) {
    const int tid = tidx(wv), wid = tid >> 6, lane = tid & 63;
    const int idx = item * 8 + wid;
    if (idx < N_EVEN * 64) {
        const int g = idx & 31, dir = (idx >> 5) & 1, j = idx >> 6;
        const float* are = P.in[dir ? I_AREB : I_AREF] + ((size_t)j * 32 + g) * 64; const float* aim = P.in[dir ? I_AIMB : I_AIMF] + ((size_t)j * 32 + g) * 64;
        const float dt = expf(P.in[dir ? I_LDTB : I_LDTF][j * 32 + g]);
        const float lre = fminf(are[lane], -1e-4f), lim = aim[lane];
        const float dec = expf(lre * dt), abr = dec * cosf(lim * dt), abi = dec * sinf(lim * dt);
        const float den = lre * lre + lim * lim;
        const float zr = ((abr - 1.f) * lre + abi * lim) / den, zi = (abi * lre - (abr - 1.f) * lim) / den;
        float* AB = (float*)(P.ws + WS_S5AB) + (size_t)idx * 128; AB[lane] = abr; AB[64 + lane] = abi;
        bf16_t* CZ = (bf16_t*)(P.ws + WS_S5CZ) + (size_t)idx * 16 * 128;
        const float* cre = P.in[I_S5CRE] + ((size_t)j * 32 + g) * 16 * 64; const float* cim = P.in[I_S5CIM] + ((size_t)j * 32 + g) * 16 * 64;
        for (int c = 0; c < 16; ++c) { const float cr = cre[c * 64 + lane], ci = cim[c * 64 + lane]; CZ[c * 128 + lane] = f2bf(cr * zr - ci * zi); CZ[c * 128 + 64 + lane] = f2bf(-(cr * zi + ci * zr)); }
        if (dir == 0) {
            bf16_t* BT = (bf16_t*)(P.ws + WS_S5BT) + ((size_t)j * 32 + g) * 128 * 16;
            const float* bre = P.in[I_S5BRE] + ((size_t)j * 32 + g) * 64 * 16; const float* bim = P.in[I_S5BIM] + ((size_t)j * 32 + g) * 64 * 16;
            for (int c = 0; c < 16; ++c) { BT[lane * 16 + c] = f2bf(bre[lane * 16 + c]); BT[(64 + lane) * 16 + c] = f2bf(bim[lane * 16 + c]); }
        }
    }
}
static __device__ __forceinline__ void phase_prologue(char* smem, const Params& P, int bid, int nb, int wv) {
    const int n_mod = DEPTH * (6 * D / 64);
    for (int it = bid; it < n_mod; it += nb) modvec_item(wv, smem, P, it);
    for (int it = bid; it < (N_EVEN * 64 + 7) / 8; it += nb) s5_tables_item(wv, P, it);
    for (int e = bid * NTHREADS + tidx(wv); e < DEPTH * D * NE; e += nb * NTHREADS) {
        const int l = e / (D * NE), k = (e / NE) % D, x = e % NE; const float w = P.in[I_RW][e]; const bf16_t hi = f2bf(w), lo = f2bf(w - bf2f(hi));
        bf16_t* dst = (bf16_t*)(P.ws + WS_RWT); dst[((size_t)(l * 2 + 0) * NE + x) * D + k] = hi; dst[((size_t)(l * 2 + 1) * NE + x) * D + k] = lo; }
    auto run = [&](const float* src, bf16_t* dst, int K, int N, int Npad, int nmat, int perm, int f8) {
        TJob J; J.src = src; J.dst = dst; J.K = K; J.N = N; J.Npad = Npad; J.nmat = nmat; J.perm = perm; J.f8 = f8;
        const int tk = K / 64, tn = (Npad + 255) / 256, per = tk * tn, total = per * nmat;
        for (int it = bid; it < total; it += nb) { const int mat = it / per, r = it % per; transpose_tile(wv, smem, J, mat, r % tk, r / tk); }
    };
    run(P.in[I_EVWIN], (bf16_t*)(P.ws + WS_WEVIN), D, P_EVEN, P_EVEN_PAD, N_EVEN, 0, 0);
    run(P.in[I_ODWIN], (bf16_t*)(P.ws + WS_WODIN), D, P_ODD, P_ODD_PAD, N_ODD, 0, 0);
    run(P.in[I_EVWOUT], (bf16_t*)(P.ws + WS_WEVOUT), D, D, D, N_EVEN, 0, 0);
    run(P.in[I_GLUW], (bf16_t*)(P.ws + WS_WGLU), 512, 512, 512, N_EVEN, 0, 0);
    run(P.in[I_ODWOUT], (bf16_t*)(P.ws + WS_WODOUT), D, D, D, N_ODD, 0, 0);
    run(P.in[I_WGU], (bf16_t*)(P.ws + WS_WGU), D, 2 * D, 2 * D, DEPTH * NE, 1, 1);
    run(P.in[I_WDN], (bf16_t*)(P.ws + WS_WDN), D, D, D, DEPTH * NE, 0, 1);
}

constexpr int MOE_RBE_MAX = 640;
static_assert(ROWS_MAX / MOE_BM <= MOE_RBE_MAX, "row-block table");
__device__ __forceinline__ void moe_offsets(int wv, const unsigned* counts, int* s_off, int* s_rbe = nullptr) {
    if (tidx(wv) == 0) { int o = 0; for (int e = 0; e < NE; ++e) { s_off[e] = o; o += (int)((counts[e] + MOE_BM - 1) / MOE_BM) * MOE_BM; } s_off[NE] = o; }
    __syncthreads();
    if (s_rbe) {
        const int e = tidx(wv);
        if (e < NE) { for (int rb = s_off[e] / MOE_BM; rb < s_off[e + 1] / MOE_BM; ++rb) s_rbe[rb] = e; s_rbe[MOE_RBE_MAX + e] = (int)counts[e]; }
        __syncthreads();
    }
}

static __device__ __forceinline__ void phase_norm1(char* smem, const Params& P, int layer, int bid, int nb, int wv) {
    int* s_off = (int*)smem;
    if (layer > 0) moe_offsets(wv, (const unsigned*)(P.ws + WS_CNT) + (layer - 1) * NE, s_off);
    const int wid = tidx(wv) >> 6, lane = tidx(wv) & 63;
    bf16_t* H = (bf16_t*)(P.ws + WS_H); bf16_t* A = (bf16_t*)(P.ws + WS_A);
    const bf16_t* YB = (const bf16_t*)(P.ws + WS_YB);
    const float* gmix = P.in[I_NMIXG] + layer * D;
    for (int r = bid * 8 + wid; r < NT; r += nb * 8) {
        float v[16];
        if (layer == 0) {
            const float* src = (r < NT_CTX) ? P.in[I_CTX] + (size_t)r * D : P.in[I_X] + (size_t)(r - NT_CTX) * D;
#pragma unroll
            for (int i = 0; i < 4; ++i) { const float4 t = *(const float4*)(src + 256 * i + 4 * lane); v[4 * i] = t.x; v[4 * i + 1] = t.y; v[4 * i + 2] = t.z; v[4 * i + 3] = t.w; }
        } else {
#pragma unroll
            for (int i = 0; i < 4; ++i) { const u32x2 t = *(const u32x2*)(H + (size_t)r * D + 256 * i + 4 * lane); v[4 * i] = bf2f((bf16_t)(t[0] & 0xffff)); v[4 * i + 1] = bf2f((bf16_t)(t[0] >> 16)); v[4 * i + 2] = bf2f((bf16_t)(t[1] & 0xffff)); v[4 * i + 3] = bf2f((bf16_t)(t[1] >> 16)); }
            const int* te = (const int*)(P.ws + WS_TOKE) + r * 4; const int* tp = (const int*)(P.ws + WS_TOKPOS) + r * 4; const float* tg = (const float*)(P.ws + WS_TOKGATE) + r * 4;
            const float* g2 = modv(P, layer - 1, r, 5);
            float mo[16];
#pragma unroll
            for (int i = 0; i < 16; ++i) mo[i] = 0.f;
#pragma unroll
            for (int k = 0; k < 4; ++k) {
                const size_t row = (size_t)(s_off[te[k]] + tp[k]); const float g = tg[k] * (1.f / F8_SY);
#pragma unroll
                for (int i = 0; i < 4; ++i) { float y[4]; unpack4f8(*(const unsigned*)((const unsigned char*)YB + row * D + 256 * i + 4 * lane), y);
                    mo[4 * i] += g * y[0]; mo[4 * i + 1] += g * y[1]; mo[4 * i + 2] += g * y[2]; mo[4 * i + 3] += g * y[3]; }
            }
#pragma unroll
            for (int i = 0; i < 4; ++i) { const float4 t = *(const float4*)(g2 + 256 * i + 4 * lane); v[4 * i] += t.x * mo[4 * i]; v[4 * i + 1] += t.y * mo[4 * i + 1]; v[4 * i + 2] += t.z * mo[4 * i + 2]; v[4 * i + 3] += t.w * mo[4 * i + 3]; }
        }
#pragma unroll
        for (int i = 0; i < 4; ++i) *(u32x2*)(H + (size_t)r * D + 256 * i + 4 * lane) = u32x2{pack2bf(v[4 * i], v[4 * i + 1]), pack2bf(v[4 * i + 2], v[4 * i + 3])};
        float ss = 0.f;
#pragma unroll
        for (int i = 0; i < 16; ++i) ss += v[i] * v[i];
        ss = wave_sum(ss, lane);
        const float rs = rsqf_(ss * (1.f / D) + 1e-6f);
        const float* sh = modv(P, layer, r, 0); const float* sc = modv(P, layer, r, 1);
#pragma unroll
        for (int i = 0; i < 4; ++i) {
            const int c = 256 * i + 4 * lane; const float4 g = *(const float4*)(gmix + c), s1 = *(const float4*)(sh + c), s2 = *(const float4*)(sc + c);
            const float a0 = v[4 * i] * rs * g.x * (1.f + s2.x) + s1.x, a1 = v[4 * i + 1] * rs * g.y * (1.f + s2.y) + s1.y, a2 = v[4 * i + 2] * rs * g.z * (1.f + s2.z) + s1.z, a3 = v[4 * i + 3] * rs * g.w * (1.f + s2.w) + s1.w;
            *(u32x2*)(A + (size_t)r * D + c) = u32x2{pack2bf(a0, a1), pack2bf(a2, a3)};
        }
    }
}

template <class Epi>
__device__ __forceinline__ void phase_gemm_dense(char* smem, const bf16_t* A, int lda, const bf16_t* Bt, int K, int M, int Npad, int bid, int nb, int wv, Epi epi) {
    const int tn = Npad / 256, tm = M / 256;
    const int xg = bid & 7, slot = bid >> 3, spx = nb >> 3;
    for (int t = slot;; t += spx) {
        const int pm = xg + 8 * (t / tn), pn = t % tn;
        if (pm >= tm) break;
        gemm_tile256(wv, smem, A, [&](int r) { return (unsigned)(pm * 256 + r) * (unsigned)lda; }, Bt + (size_t)pn * 256 * K, K, K,
                  [&](f32x4 (&acc)[2][2][4][2], int wr, int wc, int fr, int fq) { epi(acc, wr, wc, fr, fq, pm * 256, pn * 256); });
    }
}

__device__ __forceinline__ int vstep_row(int b, int dir, int v, bool colmajor) {
    if (v < CTXL) { const int t = dir ? CTXL - 1 - v : v; return b * CTXL + t; }
    int j = v - CTXL; if (dir) j = SEQ - 1 - j;
    const int t = colmajor ? (j % GROWS) * GRID_W + (j / GROWS) : j;
    return NT_CTX + b * SEQ + t;
}

static __device__ __forceinline__ void phase_conv(const Params& P, int j, int bid, int nb, int wv) {
    const bf16_t* Z = (const bf16_t*)(P.ws + WS_Z); bf16_t* QK = (bf16_t*)(P.ws + WS_QK);
    const float* cw = P.in[I_EVCONVW] + (size_t)j * 3 * D; const float* cb = P.in[I_EVCONVB] + (size_t)j * D;
    for (int e = bid * NTHREADS + tidx(wv); e < NT * 128; e += nb * NTHREADS) {
        const int r = e >> 7, c0 = (e & 127) * 8;
        int t, L; if (r < NT_CTX) { t = r % CTXL; L = CTXL; } else { t = (r - NT_CTX) % SEQ; L = SEQ; }
        const u32x4 zero = u32x4{0u, 0u, 0u, 0u};
        const u32x4 xc = *(const u32x4*)(Z + (size_t)r * ZLD + c0);
        const u32x4 xp = (t > 0) ? *(const u32x4*)(Z + (size_t)(r - 1) * ZLD + c0) : zero;
        const u32x4 xn = (t < L - 1) ? *(const u32x4*)(Z + (size_t)(r + 1) * ZLD + c0) : zero;
        const float sc = (c0 < 512) ? 0.08838834764831845f : 1.f;
        unsigned o[4];
#pragma unroll
        for (int q = 0; q < 4; ++q) {
            float y[2];
#pragma unroll
            for (int hh = 0; hh < 2; ++hh) {
                const int c = c0 + 2 * q + hh;
                const float a = bf2f((bf16_t)(hh ? (xp[q] >> 16) : (xp[q] & 0xffff))), b = bf2f((bf16_t)(hh ? (xc[q] >> 16) : (xc[q] & 0xffff))), d = bf2f((bf16_t)(hh ? (xn[q] >> 16) : (xn[q] & 0xffff)));
                const float v = cb[c] + cw[c] * a + cw[D + c] * b + cw[2 * D + c] * d;
                y[hh] = siluf_(v) * sc;
            }
            o[q] = pack2bf(y[0], y[1]);
        }
        *(u32x4*)(QK + (size_t)r * D + c0) = u32x4{o[0], o[1], o[2], o[3]};
    }
}

constexpr int ML_LDQ = 136, ML_LDS = 72;
constexpr int ML_OFF_Q = 0, ML_OFF_K = ML_OFF_Q + 64 * ML_LDQ * 2, ML_OFF_VT = ML_OFF_K + 64 * ML_LDQ * 2, ML_OFF_P = ML_OFF_VT + 144 * ML_LDS * 2,
              ML_OFF_KW = ML_OFF_P + 64 * ML_LDS * 2, ML_OFF_CT = ML_OFF_KW + 128 * ML_LDS * 2, ML_OFF_F = ML_OFF_CT + 144 * ML_LDQ * 2, ML_LDS_BYTES = ML_OFF_F + 5 * 64 * 4;
static __device__ __forceinline__ void phase_mlstm(char* smem, const Params& P, int bid, int nb, int wv) {
    const int tid = tidx(wv), wid = tid >> 6, lane = tid & 63, fr = lane & 15, fq = lane >> 4;
    bf16_t* sQ = (bf16_t*)(smem + ML_OFF_Q); bf16_t* sK = (bf16_t*)(smem + ML_OFF_K); bf16_t* sVt = (bf16_t*)(smem + ML_OFF_VT); bf16_t* sP = (bf16_t*)(smem + ML_OFF_P);
    bf16_t* sKw = (bf16_t*)(smem + ML_OFF_KW); bf16_t* sCt = (bf16_t*)(smem + ML_OFF_CT);
    float* sBc = (float*)(smem + ML_OFF_F); float* sIg = sBc + 64; float* sWg = sBc + 128; float* sDen = sBc + 192; float* sEb = sBc + 256;
    const bf16_t* QK = (const bf16_t*)(P.ws + WS_QK); const bf16_t* Z = (const bf16_t*)(P.ws + WS_Z); const float* G = (const float*)(P.ws + WS_GATES);
    bf16_t* MO = (bf16_t*)(P.ws + WS_MO);
    for (int it = bid; it < BATCH * 8; it += nb) {
        const int dir = it & 1, head = (it >> 1) & 3, b = it >> 3;
        for (int e = tid; e < 144 * ML_LDQ; e += NTHREADS) sCt[e] = 0;
        for (int e = tid; e < 16 * ML_LDS; e += NTHREADS) sVt[128 * ML_LDS + e] = (e < 64) ? (bf16_t)0x3F80 : (bf16_t)0;
        f32x4 Cacc[9];
#pragma unroll
        for (int n = 0; n < 9; ++n) Cacc[n] = f32x4{0.f, 0.f, 0.f, 0.f};
        __syncthreads();
        u32x4 pq[2], pk[2], pv[2]; float pig = 0.f, pfg = 0.f;
        auto issue = [&](int ci) {
#pragma unroll
            for (int i = 0; i < 2; ++i) {
                const int id = tid + i * 512, s = id >> 4, ch = id & 15; const int row = vstep_row(b, dir, ci * 64 + s, false);
                pq[i] = *(const u32x4*)(QK + (size_t)row * D + head * 128 + ch * 8);
                pk[i] = *(const u32x4*)(QK + (size_t)row * D + 512 + head * 128 + ch * 8);
            }
#pragma unroll
            for (int i = 0; i < 2; ++i) { const int id = tid + i * 512, s = id >> 4, ch = id & 15; const int row = vstep_row(b, dir, ci * 64 + s, false); pv[i] = *(const u32x4*)(Z + (size_t)row * ZLD + 1024 + head * 128 + ch * 8); }
            if (wid == 0) { const int row = vstep_row(b, dir, ci * 64 + lane, false); pig = G[(size_t)row * 32 + (dir * 2) * 4 + head]; pfg = G[(size_t)row * 32 + (dir * 2 + 1) * 4 + head]; }
        };
        issue(0);
        for (int ci = 0; ci < NCH; ++ci) {
            {
                u32x4 cq[2], ck[2], cv[2]; const float cig = pig, cfg = pfg;
#pragma unroll
                for (int i = 0; i < 2; ++i) { cq[i] = pq[i]; ck[i] = pk[i]; cv[i] = pv[i]; }
                if (ci + 1 < NCH) issue(ci + 1);
#pragma unroll
                for (int i = 0; i < 2; ++i) {
                    const int id = tid + i * 512, s = id >> 4, ch = id & 15;
                    *(u32x4*)(sQ + s * ML_LDQ + ch * 8) = cq[i];
                    *(u32x4*)(sK + s * ML_LDQ + ch * 8) = ck[i];
                }
#pragma unroll
                for (int i = 0; i < 2; ++i) {
                    const int id = tid + i * 512, s = id >> 4, ch = id & 15;
#pragma unroll
                    for (int q = 0; q < 4; ++q) { sVt[(ch * 8 + 2 * q) * ML_LDS + s] = (bf16_t)(cv[i][q] & 0xffff); sVt[(ch * 8 + 2 * q + 1) * ML_LDS + s] = (bf16_t)(cv[i][q] >> 16); }
                }
                if (wid == 0) {
                    const float ig = cig;
                    float c = logsigmoid_fast(cfg);
                    for (int d = 1; d < 64; d <<= 1) { const float n = shfl_from(c, (lane >= d) ? lane - d : lane, lane); if (lane >= d) c += n; }
                    const float bl = shfl_from(c, 63, lane);
                    sBc[lane] = c; sIg[lane] = ig; sWg[lane] = __expf(bl - c + ig); sEb[lane] = __expf(c);
                }
            }
            __syncthreads();
            {
                const int tt = wid >> 1;
                bf16x8 qa[4];
#pragma unroll
                for (int kk = 0; kk < 4; ++kk) qa[kk] = *(const bf16x8*)(sQ + (tt * 16 + fr) * ML_LDQ + kk * 32 + fq * 8);
#pragma unroll
                for (int u = 0; u < 2; ++u) {
                    const int st = (wid & 1) * 2 + u;
                    f32x4 acc = f32x4{0.f, 0.f, 0.f, 0.f};
#pragma unroll
                    for (int kk = 0; kk < 4; ++kk) {
                        const bf16x8 bb = *(const bf16x8*)(sK + (st * 16 + fr) * ML_LDQ + kk * 32 + fq * 8);
                        acc = MFMA16(qa[kk], bb, acc);
                    }
                    const int s = st * 16 + fr; const float bs = sBc[s], is = sIg[s];
#pragma unroll
                    for (int j = 0; j < 4; ++j) { const int t = tt * 16 + fq * 4 + j; const float w = (s <= t) ? __expf(sBc[t] - bs + is) : 0.f; sP[t * ML_LDS + s] = f2bf(acc[j] * w); }
                }
#pragma unroll
                for (int i = 0; i < 16; ++i) { const int e = tid + i * 512, s = e & 63, d = e >> 6; sKw[d * ML_LDS + s] = f2bf(bf2f(sK[s * ML_LDQ + d]) * sWg[s]); }
            }
            __syncthreads();
            const int tt = wid & 3, e0 = (wid < 4) ? 0 : 5, ne = (wid < 4) ? 5 : 4;
            f32x4 val[5];
            bf16x8 pa[2], qa[4];
#pragma unroll
            for (int kk = 0; kk < 2; ++kk) pa[kk] = *(const bf16x8*)(sP + (tt * 16 + fr) * ML_LDS + kk * 32 + fq * 8);
#pragma unroll
            for (int kk = 0; kk < 4; ++kk) qa[kk] = *(const bf16x8*)(sQ + (tt * 16 + fr) * ML_LDQ + kk * 32 + fq * 8);
#pragma unroll
            for (int u = 0; u < 5; ++u) {
                val[u] = f32x4{0.f, 0.f, 0.f, 0.f};
                if (u < ne) {
                    const int et = e0 + u;
                    f32x4 ai = f32x4{0.f, 0.f, 0.f, 0.f}, ao = f32x4{0.f, 0.f, 0.f, 0.f};
#pragma unroll
                    for (int kk = 0; kk < 2; ++kk) {
                        const bf16x8 bb = *(const bf16x8*)(sVt + (et * 16 + fr) * ML_LDS + kk * 32 + fq * 8);
                        ai = MFMA16(bb, pa[kk], ai);
                    }
#pragma unroll
                    for (int kk = 0; kk < 4; ++kk) {
                        const bf16x8 bb = *(const bf16x8*)(sCt + (et * 16 + fr) * ML_LDQ + kk * 32 + fq * 8);
                        ao = MFMA16(bb, qa[kk], ao);
                    }
                    const float eb = sEb[tt * 16 + fr];
#pragma unroll
                    for (int j = 0; j < 4; ++j) val[u][j] = ai[j] + eb * ao[j];
                    if (et == 8 && fq == 0) sDen[tt * 16 + fr] = val[u][0];
                }
            }
            __syncthreads();
            {
                const int t = tt * 16 + fr; const int row = vstep_row(b, dir, ci * 64 + t, false);
                const float dn = rcpf_(fmaxf(fabsf(sDen[t]), 1.f));
#pragma unroll
                for (int u = 0; u < 5; ++u) {
                    const int et = e0 + u;
                    if (u < ne && et < 8) *(u32x2*)(MO + ((size_t)dir * NT + row) * D + head * 128 + et * 16 + fq * 4) = u32x2{pack2bf(val[u][0] * dn, val[u][1] * dn), pack2bf(val[u][2] * dn, val[u][3] * dn)};
                }
            }
            {
                const float dec = sEb[63];
                bf16x8 ka[2];
#pragma unroll
                for (int kk = 0; kk < 2; ++kk) ka[kk] = *(const bf16x8*)(sKw + (wid * 16 + fr) * ML_LDS + kk * 32 + fq * 8);
#pragma unroll
                for (int n = 0; n < 9; ++n) {
                    f32x4 c = Cacc[n] * dec;
#pragma unroll
                    for (int kk = 0; kk < 2; ++kk) {
                        const bf16x8 bb = *(const bf16x8*)(sVt + (n * 16 + fr) * ML_LDS + kk * 32 + fq * 8);
                        c = MFMA16(ka[kk], bb, c);
                    }
                    Cacc[n] = c;
                    *(u32x2*)(sCt + (n * 16 + fr) * ML_LDQ + wid * 16 + fq * 4) = u32x2{pack2bf(c[0], c[1]), pack2bf(c[2], c[3])};
                }
            }
            __syncthreads();
        }
    }
}

#ifdef HOST_EMU
#define WAVE_SYNC() do { int _z = 0; (void)emu::wave_exchange(&_z, 4); } while (0)
#else
#define WAVE_SYNC() __builtin_amdgcn_wave_barrier()
#endif

constexpr int S5_LDW = 132;
constexpr int S5_WAVE_BYTES = 32 * S5_LDW * 4 + 128 * 4, S5_LDS_BYTES = 8 * S5_WAVE_BYTES;
static __device__ __forceinline__ void phase_s5(char* smem, const Params& P, int j, int bid, int nb, int wv) {
    const int tid = tidx(wv), wid = tid >> 6, lane = tid & 63, fr = lane & 15, fq = lane >> 4;
    float* BU = (float*)(smem + wid * S5_WAVE_BYTES);
    const bf16_t* Z = (const bf16_t*)(P.ws + WS_Z); bf16_t* MO = (bf16_t*)(P.ws + WS_MO);
    for (int it = bid * 8 + wid; it < BATCH * 2 * 32; it += nb * 8) {
        const int g = it & 31, dir = (it >> 5) & 1, b = it >> 6;
        const int idx = (j * 2 + dir) * 32 + g;
        const float* AB = (const float*)(P.ws + WS_S5AB) + (size_t)idx * 128;
        const float abr = AB[lane], abi = AB[64 + lane];
        bf16x8 bop[4];
        {
            const bf16_t* BT = (const bf16_t*)(P.ws + WS_S5BT) + ((size_t)j * 32 + g) * 128 * 16;
#pragma unroll
            for (int nt = 0; nt < 4; ++nt) bop[nt] = *(const bf16x8*)(BT + (nt * 32 + (lane & 31)) * 16 + 8 * (lane >> 5));
        }
        bf16x8 cop[4];
        {
            const bf16_t* CZ = (const bf16_t*)(P.ws + WS_S5CZ) + (size_t)idx * 16 * 128;
#pragma unroll
            for (int kk = 0; kk < 4; ++kk) cop[kk] = *(const bf16x8*)(CZ + fr * 128 + kk * 32 + 8 * fq);
        }
        float sre = 0.f, sim = 0.f;
        bf16x8 ua_nx = *(const bf16x8*)(Z + (size_t)vstep_row(b, dir, (lane & 31), false) * ZLD + 2064 + g * 16 + 8 * (lane >> 5));
        for (int c32 = 0; c32 < (CTXL + SEQ) / 32; ++c32) {
            const bf16x8 ua = ua_nx;
            if (c32 + 1 < (CTXL + SEQ) / 32) ua_nx = *(const bf16x8*)(Z + (size_t)vstep_row(b, dir, (c32 + 1) * 32 + (lane & 31), false) * ZLD + 2064 + g * 16 + 8 * (lane >> 5));
#pragma unroll
            for (int nt = 0; nt < 4; ++nt) {
                f32x16 d;
#pragma unroll
                for (int q = 0; q < 16; ++q) d[q] = 0.f;
                d = MFMA32(ua, bop[nt], d);
#pragma unroll
                for (int q = 0; q < 16; ++q) BU[((q & 3) + 8 * (q >> 2) + 4 * (lane >> 5)) * S5_LDW + nt * 32 + (lane & 31)] = d[q];
            }
            WAVE_SYNC();
            {
                float br[32], bi[32];
#pragma unroll
                for (int s = 0; s < 32; ++s) { br[s] = BU[s * S5_LDW + lane]; bi[s] = BU[s * S5_LDW + 64 + lane]; }
#ifndef HOST_EMU
                asm volatile("s_waitcnt lgkmcnt(0)" ::: "memory");
#endif
#pragma unroll
                for (int s = 0; s < 32; ++s) {
                    const float nr = abr * sre - abi * sim + br[s], ni = abr * sim + abi * sre + bi[s];
                    sre = nr; sim = ni; br[s] = nr; bi[s] = ni;
                }
#pragma unroll
                for (int s = 0; s < 32; ++s) { BU[s * S5_LDW + lane] = br[s]; BU[s * S5_LDW + 64 + lane] = bi[s]; }
#ifndef HOST_EMU
                asm volatile("s_waitcnt lgkmcnt(0)" ::: "memory");
#endif
            }
            WAVE_SYNC();
#pragma unroll
            for (int mt = 0; mt < 2; ++mt) {
                f32x4 acc = f32x4{0.f, 0.f, 0.f, 0.f};
#pragma unroll
                for (int kk = 0; kk < 4; ++kk) {
                    const float* sp = BU + (mt * 16 + fr) * S5_LDW + kk * 32 + fq * 8;
                    const float4 x0 = *(const float4*)sp, x1 = *(const float4*)(sp + 4);
                    bf16x8 a; a[0] = (short)f2bf(x0.x); a[1] = (short)f2bf(x0.y); a[2] = (short)f2bf(x0.z); a[3] = (short)f2bf(x0.w);
                    a[4] = (short)f2bf(x1.x); a[5] = (short)f2bf(x1.y); a[6] = (short)f2bf(x1.z); a[7] = (short)f2bf(x1.w);
                    acc = MFMA16(a, cop[kk], acc);
                }
#pragma unroll
                for (int q = 0; q < 4; ++q) { const int row = vstep_row(b, dir, c32 * 32 + mt * 16 + fq * 4 + q, false); MO[((size_t)dir * NT + row) * D + 512 + g * 16 + fr] = f2bf(acc[q]); }
            }
            WAVE_SYNC();
        }
    }
}

static __device__ __forceinline__ void phase_post_even(const Params& P, int j, int bid, int nb, int wv) {
    const int wid = tidx(wv) >> 6, lane = tidx(wv) & 63;
    const bf16_t* MO = (const bf16_t*)(P.ws + WS_MO); const bf16_t* Z = (const bf16_t*)(P.ws + WS_Z);
    bf16_t* CAT = (bf16_t*)(P.ws + WS_CAT); bf16_t* YY = (bf16_t*)(P.ws + WS_YY);
    const float* mg = P.in[I_EVMNORM] + (size_t)j * 512; const float* dsk = P.in[I_S5D] + (size_t)j * 512;
    for (int r = bid * 8 + wid; r < NT; r += nb * 8) {
        const int c0 = lane * 8;
        float m[8], s[8];
        {
            const u32x4 a0 = *(const u32x4*)(MO + (size_t)r * D + c0), b0 = *(const u32x4*)(MO + ((size_t)NT + r) * D + c0);
            const u32x4 a1 = *(const u32x4*)(MO + (size_t)r * D + 512 + c0), b1 = *(const u32x4*)(MO + ((size_t)NT + r) * D + 512 + c0);
#pragma unroll
            for (int q = 0; q < 4; ++q) {
                m[2 * q] = bf2f((bf16_t)(a0[q] & 0xffff)) + bf2f((bf16_t)(b0[q] & 0xffff)); m[2 * q + 1] = bf2f((bf16_t)(a0[q] >> 16)) + bf2f((bf16_t)(b0[q] >> 16));
                s[2 * q] = bf2f((bf16_t)(a1[q] & 0xffff)) + bf2f((bf16_t)(b1[q] & 0xffff)); s[2 * q + 1] = bf2f((bf16_t)(a1[q] >> 16)) + bf2f((bf16_t)(b1[q] >> 16));
            }
        }
        float ss = 0.f;
#pragma unroll
        for (int q = 0; q < 8; ++q) ss += m[q] * m[q];
        ss = group16_sum(ss, lane);
        const float rs = rsqf_(ss * (1.f / 128.f) + 1e-6f);
        const u32x4 ov = *(const u32x4*)(Z + (size_t)r * ZLD + 1536 + c0);
        const u32x4 uv = *(const u32x4*)(Z + (size_t)r * ZLD + 2064 + c0);
        unsigned o1[4], o2[4];
#pragma unroll
        for (int q = 0; q < 4; ++q) {
            const float oa = bf2f((bf16_t)(ov[q] & 0xffff)), ob = bf2f((bf16_t)(ov[q] >> 16));
            const float ua = bf2f((bf16_t)(uv[q] & 0xffff)), ub = bf2f((bf16_t)(uv[q] >> 16));
            const float ma = m[2 * q] * rs * mg[c0 + 2 * q] * sigmoidf_(oa), mb = m[2 * q + 1] * rs * mg[c0 + 2 * q + 1] * sigmoidf_(ob);
            const float ya = gelu_tanhf_(s[2 * q] + dsk[c0 + 2 * q] * ua), yb = gelu_tanhf_(s[2 * q + 1] + dsk[c0 + 2 * q + 1] * ub);
            o1[q] = pack2bf(ma, mb); o2[q] = pack2bf(ya, yb);
        }
        *(u32x4*)(CAT + (size_t)r * D + c0) = u32x4{o1[0], o1[1], o1[2], o1[3]};
        *(u32x4*)(YY + (size_t)r * 512 + c0) = u32x4{o2[0], o2[1], o2[2], o2[3]};
    }
}

static __device__ __forceinline__ void phase_post_odd(const Params& P, int j, int bid, int nb, int wv) {
    const int wid = tidx(wv) >> 6, lane = tidx(wv) & 63;
    const bf16_t* MO = (const bf16_t*)(P.ws + WS_MO); const bf16_t* Z = (const bf16_t*)(P.ws + WS_Z); bf16_t* CAT = (bf16_t*)(P.ws + WS_CAT);
    const float* ng = P.in[I_ODNORM] + (size_t)j * D;
    for (int r = bid * 8 + wid; r < NT; r += nb * 8) {
        const int c0 = lane * 16;
        float o[16];
        {
#pragma unroll
            for (int hh = 0; hh < 2; ++hh) {
                const u32x4 a = *(const u32x4*)(MO + (size_t)r * D + c0 + hh * 8), bq = *(const u32x4*)(MO + ((size_t)NT + r) * D + c0 + hh * 8);
#pragma unroll
                for (int q = 0; q < 4; ++q) { o[hh * 8 + 2 * q] = bf2f((bf16_t)(a[q] & 0xffff)) + bf2f((bf16_t)(bq[q] & 0xffff)); o[hh * 8 + 2 * q + 1] = bf2f((bf16_t)(a[q] >> 16)) + bf2f((bf16_t)(bq[q] >> 16)); }
            }
        }
        float ss = 0.f;
#pragma unroll
        for (int q = 0; q < 16; ++q) ss += o[q] * o[q];
        ss = group16_sum(ss, lane);
        const float rs = rsqf_(ss * (1.f / 256.f) + 1e-6f);
#pragma unroll
        for (int hh = 0; hh < 2; ++hh) {
            const u32x4 gv = *(const u32x4*)(Z + (size_t)r * ZLD + 2048 + c0 + hh * 8);
            unsigned w[4];
#pragma unroll
            for (int q = 0; q < 4; ++q) {
                const int c = c0 + hh * 8 + 2 * q;
                const float ga = bf2f((bf16_t)(gv[q] & 0xffff)), gb = bf2f((bf16_t)(gv[q] >> 16));
                w[q] = pack2bf(o[hh * 8 + 2 * q] * rs * ng[c] * siluf_(ga), o[hh * 8 + 2 * q + 1] * rs * ng[c + 1] * siluf_(gb));
            }
            *(u32x4*)(CAT + (size_t)r * D + c0 + hh * 8) = u32x4{w[0], w[1], w[2], w[3]};
        }
    }
}

constexpr int GL_LDQ = 136, GL_LDS = 72, GL_LDB = 129;
constexpr int GL_OFF_Q = 0, GL_OFF_K = GL_OFF_Q + 64 * GL_LDQ * 2, GL_OFF_KD = GL_OFF_K + 64 * GL_LDQ * 2, GL_OFF_VT = GL_OFF_KD + 128 * GL_LDS * 2, GL_OFF_P = GL_OFF_VT + 128 * GL_LDS * 2,
              GL_OFF_ST = GL_OFF_P + 64 * GL_LDS * 2, GL_OFF_B = GL_OFF_ST + 128 * GL_LDQ * 2, GL_OFF_R = GL_OFF_B + 64 * GL_LDB * 4, GL_OFF_TOT = GL_OFF_R + 64 * 16 * 4, GL_LDS_BYTES = GL_OFF_TOT + 4 * 128 * 4;
static __device__ __forceinline__ void phase_gla(char* smem, const Params& P, int j, int bid, int nb, int wv) {
    const int tid = tidx(wv), wid = tid >> 6, lane = tid & 63, fr = lane & 15, fq = lane >> 4;
    bf16_t* sQ = (bf16_t*)(smem + GL_OFF_Q); bf16_t* sK = (bf16_t*)(smem + GL_OFF_K); bf16_t* sKd = (bf16_t*)(smem + GL_OFF_KD); bf16_t* sVt = (bf16_t*)(smem + GL_OFF_VT);
    bf16_t* sP = (bf16_t*)(smem + GL_OFF_P); bf16_t* sSt = (bf16_t*)(smem + GL_OFF_ST); float* sB = (float*)(smem + GL_OFF_B); float* sR = (float*)(smem + GL_OFF_R); float* sTot = (float*)(smem + GL_OFF_TOT);
    const bf16_t* Z = (const bf16_t*)(P.ws + WS_Z); const float* G = (const float*)(P.ws + WS_GATES); bf16_t* MO = (bf16_t*)(P.ws + WS_MO);
    for (int it = bid; it < BATCH * 16; it += nb) {
        const int hf = it & 1, dir = (it >> 1) & 1, head = (it >> 2) & 3, b = it >> 4;
        const float* w2 = P.in[dir ? I_ODW2B : I_ODW2F] + (size_t)j * 16 * 512; const float* b2 = P.in[dir ? I_ODB2B : I_ODB2F] + (size_t)j * 512;
        const int dcol = tid & 127, sg = tid >> 7;
        float w2c[16];
#pragma unroll
        for (int q = 0; q < 16; ++q) w2c[q] = w2[q * 512 + head * 128 + dcol];
        const float b2c = b2[head * 128 + dcol];
        for (int e = tid; e < 128 * GL_LDQ; e += NTHREADS) sSt[e] = 0;
        f32x4 Sacc[8];
#pragma unroll
        for (int n = 0; n < 8; ++n) Sacc[n] = f32x4{0.f, 0.f, 0.f, 0.f};
        __syncthreads();
        for (int ci = 0; ci < NCH; ++ci) {
            if (tid < 256) { const int s = tid >> 2, q4 = tid & 3; const int row = vstep_row(b, dir, ci * 64 + s, true); *(float4*)(sR + s * 16 + q4 * 4) = *(const float4*)(G + (size_t)row * 32 + dir * 16 + q4 * 4); }
            __syncthreads();
            float la[16]; float run = 0.f;
#pragma unroll
            for (int i = 0; i < 16; ++i) {
                const int s = sg * 16 + i; float x = b2c;
#pragma unroll
                for (int q = 0; q < 16; ++q) x += sR[s * 16 + q] * w2c[q];
                run += logsigmoidf_(x) * (1.f / 16.f); la[i] = run;
            }
            sTot[sg * 128 + dcol] = run;
            __syncthreads();
            {
                float pre = 0.f;
#pragma unroll
                for (int q = 0; q < 3; ++q) if (q < sg) pre += sTot[q * 128 + dcol];
#pragma unroll
                for (int i = 0; i < 16; ++i) sB[(sg * 16 + i) * GL_LDB + dcol] = la[i] + pre;
            }
            __syncthreads();
#pragma unroll
            for (int i = 0; i < 2; ++i) {
                const int id = tid + i * 512, s = id >> 4, ch = id & 15; const int row = vstep_row(b, dir, ci * 64 + s, true);
                const u32x4 qv = *(const u32x4*)(Z + (size_t)row * ZLD + head * 128 + ch * 8);
                const u32x4 kv = *(const u32x4*)(Z + (size_t)row * ZLD + 512 + head * 128 + ch * 8);
                const u32x4 vv = *(const u32x4*)(Z + (size_t)row * ZLD + 1024 + head * 256 + hf * 128 + ch * 8);
                unsigned qo[4], ko[4];
#pragma unroll
                for (int q = 0; q < 4; ++q) {
                    const int d0 = ch * 8 + 2 * q;
                    const float bA = sB[s * GL_LDB + d0], bB = sB[s * GL_LDB + d0 + 1], lA = sB[63 * GL_LDB + d0], lB = sB[63 * GL_LDB + d0 + 1];
                    const float qa = bf2f((bf16_t)(qv[q] & 0xffff)) * 0.08838834764831845f, qb = bf2f((bf16_t)(qv[q] >> 16)) * 0.08838834764831845f;
                    const float ka = bf2f((bf16_t)(kv[q] & 0xffff)), kb = bf2f((bf16_t)(kv[q] >> 16));
                    qo[q] = pack2bf(qa * __expf(bA), qb * __expf(bB)); ko[q] = pack2bf(ka * __expf(-bA), kb * __expf(-bB));
                    sKd[d0 * GL_LDS + s] = f2bf(ka * __expf(lA - bA)); sKd[(d0 + 1) * GL_LDS + s] = f2bf(kb * __expf(lB - bB));
                    sVt[d0 * GL_LDS + s] = (bf16_t)(vv[q] & 0xffff); sVt[(d0 + 1) * GL_LDS + s] = (bf16_t)(vv[q] >> 16);
                }
                *(u32x4*)(sQ + s * GL_LDQ + ch * 8) = u32x4{qo[0], qo[1], qo[2], qo[3]};
                *(u32x4*)(sK + s * GL_LDQ + ch * 8) = u32x4{ko[0], ko[1], ko[2], ko[3]};
            }
            __syncthreads();
            {
                const int tt = wid >> 1;
#pragma unroll
                for (int u = 0; u < 2; ++u) {
                    const int st = (wid & 1) * 2 + u;
                    f32x4 acc = f32x4{0.f, 0.f, 0.f, 0.f};
#pragma unroll
                    for (int kk = 0; kk < 4; ++kk) {
                        const bf16x8 a = *(const bf16x8*)(sQ + (tt * 16 + fr) * GL_LDQ + kk * 32 + fq * 8);
                        const bf16x8 bb = *(const bf16x8*)(sK + (st * 16 + fr) * GL_LDQ + kk * 32 + fq * 8);
                        acc = MFMA16(a, bb, acc);
                    }
                    const int s = st * 16 + fr;
#pragma unroll
                    for (int q = 0; q < 4; ++q) { const int t = tt * 16 + fq * 4 + q; sP[t * GL_LDS + s] = f2bf((s <= t) ? acc[q] : 0.f); }
                }
            }
            __syncthreads();
            {
                const int tt = wid & 3;
#pragma unroll
                for (int u = 0; u < 4; ++u) {
                    const int et = (wid >> 2) * 4 + u;
                    f32x4 acc = f32x4{0.f, 0.f, 0.f, 0.f};
#pragma unroll
                    for (int kk = 0; kk < 2; ++kk) {
                        const bf16x8 a = *(const bf16x8*)(sP + (tt * 16 + fr) * GL_LDS + kk * 32 + fq * 8);
                        const bf16x8 bb = *(const bf16x8*)(sVt + (et * 16 + fr) * GL_LDS + kk * 32 + fq * 8);
                        acc = MFMA16(a, bb, acc);
                    }
#pragma unroll
                    for (int kk = 0; kk < 4; ++kk) {
                        const bf16x8 a = *(const bf16x8*)(sQ + (tt * 16 + fr) * GL_LDQ + kk * 32 + fq * 8);
                        const bf16x8 bb = *(const bf16x8*)(sSt + (et * 16 + fr) * GL_LDQ + kk * 32 + fq * 8);
                        acc = MFMA16(a, bb, acc);
                    }
#pragma unroll
                    for (int q = 0; q < 4; ++q) { const int t = tt * 16 + fq * 4 + q; const int row = vstep_row(b, dir, ci * 64 + t, true); MO[((size_t)dir * NT + row) * D + head * 256 + hf * 128 + et * 16 + fr] = f2bf(acc[q]); }
                }
            }
            __syncthreads();
            {
                float dec[4];
#pragma unroll
                for (int q = 0; q < 4; ++q) dec[q] = __expf(sB[63 * GL_LDB + wid * 16 + fq * 4 + q]);
#pragma unroll
                for (int n = 0; n < 8; ++n) {
                    f32x4 c = Sacc[n];
#pragma unroll
                    for (int q = 0; q < 4; ++q) c[q] *= dec[q];
#pragma unroll
                    for (int kk = 0; kk < 2; ++kk) {
                        const bf16x8 a = *(const bf16x8*)(sKd + (wid * 16 + fr) * GL_LDS + kk * 32 + fq * 8);
                        const bf16x8 bb = *(const bf16x8*)(sVt + (n * 16 + fr) * GL_LDS + kk * 32 + fq * 8);
                        c = MFMA16(a, bb, c);
                    }
                    Sacc[n] = c;
                    *(u32x2*)(sSt + (n * 16 + fr) * GL_LDQ + wid * 16 + fq * 4) = u32x2{pack2bf(c[0], c[1]), pack2bf(c[2], c[3])};
                }
            }
            __syncthreads();
        }
    }
}

__device__ __forceinline__ int img256(int r, int c) { return r * 256 + ((c ^ (r & 15)) << 4); }
__device__ __forceinline__ int img128(int r, int c) { return r * 128 + ((c ^ (r & 7)) << 4); }
constexpr int GP_OFF_KT = 73728, GP_OFF_B = GP_OFF_KT + 64 * 136 * 2, GP_OFF_R = GP_OFF_B + 64 * 129 * 4, GP_OFF_TOT = GP_OFF_R + 64 * 16 * 4, GP_LDS_BYTES = GP_OFF_TOT + 4 * 128 * 4;
static __device__ __forceinline__ void phase_gla_prep(char* smem, const Params& P, int j, int bid, int nb, int wv) {
    const int tid = tidx(wv), wid = tid >> 6, lane = tid & 63, fr = lane & 15, fq = lane >> 4;
    bf16_t* sKt = (bf16_t*)(smem + GP_OFF_KT); float* sB = (float*)(smem + GP_OFF_B); float* sR = (float*)(smem + GP_OFF_R); float* sTot = (float*)(smem + GP_OFF_TOT);
    const bf16_t* Z = (const bf16_t*)(P.ws + WS_Z); const float* G = (const float*)(P.ws + WS_GATES);
    const int dcol = tid & 127, sg = tid >> 7;
    const int total = BATCH * 2 * NCH * 4;
    float4 rv = make_float4(0.f, 0.f, 0.f, 0.f); u32x4 qv[2], kv[2], vv[4];
#pragma unroll
    for (int i = 0; i < 2; ++i) { qv[i] = u32x4{0u, 0u, 0u, 0u}; kv[i] = qv[i]; }
#pragma unroll
    for (int i = 0; i < 4; ++i) vv[i] = u32x4{0u, 0u, 0u, 0u};
    auto issue = [&](int itx) {
        const int head = itx & 3, ci = (itx >> 2) % NCH, dir = ((itx >> 2) / NCH) & 1, b = (itx >> 2) / (2 * NCH);
        if (tid < 256) { const int s = tid >> 2, q4 = tid & 3; const int row = vstep_row(b, dir, ci * 64 + s, true); rv = *(const float4*)(G + (size_t)row * 32 + dir * 16 + q4 * 4); }
        const int row = vstep_row(b, dir, ci * 64 + lane, true);
        const bf16_t* zr = Z + (size_t)row * ZLD;
#pragma unroll
        for (int i = 0; i < 2; ++i) { qv[i] = *(const u32x4*)(zr + head * 128 + wid * 16 + i * 8); kv[i] = *(const u32x4*)(zr + 512 + head * 128 + wid * 16 + i * 8); }
#pragma unroll
        for (int i = 0; i < 4; ++i) vv[i] = *(const u32x4*)(zr + 1024 + head * 256 + wid * 32 + i * 8);
    };
    if (bid < total) issue(bid);
    for (int it = bid; it < total; it += nb) {
        const int head = it & 3, dir = ((it >> 2) / NCH) & 1;
        const float* w2 = P.in[dir ? I_ODW2B : I_ODW2F] + (size_t)j * 16 * 512; const float* b2 = P.in[dir ? I_ODB2B : I_ODB2F] + (size_t)j * 512;
        float w2c[16];
#pragma unroll
        for (int q = 0; q < 16; ++q) w2c[q] = w2[q * 512 + head * 128 + dcol];
        const float b2c = b2[head * 128 + dcol];
        const float4 rc = rv; u32x4 qc[2], kc[2], vc[4];
#pragma unroll
        for (int i = 0; i < 2; ++i) { qc[i] = qv[i]; kc[i] = kv[i]; }
#pragma unroll
        for (int i = 0; i < 4; ++i) vc[i] = vv[i];
        if (it + nb < total) issue(it + nb);
        if (tid < 256) { const int s = tid >> 2, q4 = tid & 3; *(float4*)(sR + s * 16 + q4 * 4) = rc; }
        __syncthreads();
        float la[16]; float run = 0.f;
#pragma unroll
        for (int i = 0; i < 16; ++i) {
            const int s = sg * 16 + i; float x = b2c;
#pragma unroll
            for (int q = 0; q < 16; ++q) x += sR[s * 16 + q] * w2c[q];
            run += logsigmoid_fast(x) * (1.f / 16.f); la[i] = run;
        }
        sTot[sg * 128 + dcol] = run;
        __syncthreads();
        {
            float pre = 0.f;
#pragma unroll
            for (int q = 0; q < 3; ++q) if (q < sg) pre += sTot[q * 128 + dcol];
#pragma unroll
            for (int i = 0; i < 16; ++i) sB[(sg * 16 + i) * 129 + dcol] = la[i] + pre;
        }
        __syncthreads();
        {
            const int s = lane;
#pragma unroll
            for (int i = 0; i < 2; ++i) {
                unsigned qo[4], ko[4];
#pragma unroll
                for (int q = 0; q < 4; ++q) {
                    const int d0 = wid * 16 + i * 8 + 2 * q;
                    const float bA = sB[s * 129 + d0], bB = sB[s * 129 + d0 + 1], lA = sB[63 * 129 + d0], lB = sB[63 * 129 + d0 + 1];
                    const float qa = bf2f((bf16_t)(qc[i][q] & 0xffff)) * 0.08838834764831845f, qb = bf2f((bf16_t)(qc[i][q] >> 16)) * 0.08838834764831845f;
                    const float ka = bf2f((bf16_t)(kc[i][q] & 0xffff)), kb = bf2f((bf16_t)(kc[i][q] >> 16));
                    qo[q] = pack2bf(qa * __expf(bA), qb * __expf(bB)); ko[q] = pack2bf(ka * __expf(-bA), kb * __expf(-bB));
                    *(bf16_t*)(smem + GI_KD + img128(d0, s >> 3) + (s & 7) * 2) = f2bf(ka * __expf(lA - bA));
                    *(bf16_t*)(smem + GI_KD + img128(d0 + 1, s >> 3) + (s & 7) * 2) = f2bf(kb * __expf(lB - bB));
                }
                *(u32x4*)(smem + GI_Q + img256(s, wid * 2 + i)) = u32x4{qo[0], qo[1], qo[2], qo[3]};
                *(u32x4*)(sKt + s * 136 + (wid * 2 + i) * 8) = u32x4{ko[0], ko[1], ko[2], ko[3]};
            }
            const int hf = wid >> 2;
#pragma unroll
            for (int i = 0; i < 4; ++i) {
                const int e0 = (wid & 3) * 32 + i * 8;
#pragma unroll
                for (int q = 0; q < 4; ++q) {
                    *(bf16_t*)(smem + GI_VT + hf * 16384 + img128(e0 + 2 * q, s >> 3) + (s & 7) * 2) = (bf16_t)(vc[i][q] & 0xffff);
                    *(bf16_t*)(smem + GI_VT + hf * 16384 + img128(e0 + 2 * q + 1, s >> 3) + (s & 7) * 2) = (bf16_t)(vc[i][q] >> 16);
                }
            }
        }
        __syncthreads();
        {
            const int tt = wid >> 1;
#pragma unroll
            for (int u = 0; u < 2; ++u) {
                const int st = (wid & 1) * 2 + u;
                f32x4 acc = f32x4{0.f, 0.f, 0.f, 0.f};
#pragma unroll
                for (int kk = 0; kk < 4; ++kk) {
                    const bf16x8 a = *(const bf16x8*)(smem + GI_Q + img256(tt * 16 + fr, kk * 4 + fq));
                    const bf16x8 bb = *(const bf16x8*)(sKt + (st * 16 + fr) * 136 + kk * 32 + fq * 8);
                    acc = MFMA16(a, bb, acc);
                }
                const int sidx = st * 16 + fr;
#pragma unroll
                for (int q = 0; q < 4; ++q) { const int t = tt * 16 + fq * 4 + q; *(bf16_t*)(smem + GI_P + img128(t, sidx >> 3) + (sidx & 7) * 2) = f2bf((sidx <= t) ? acc[q] : 0.f); }
            }
        }
        __syncthreads();
        {
            char* dst = P.ws + WS_GIMG + (size_t)it * GI_BYTES;
#pragma unroll
            for (int i = 0; i < 9; ++i) *(u32x4*)(dst + (tid + i * 512) * 16) = *(const u32x4*)(smem + (tid + i * 512) * 16);
            if (tid < 128) ((float*)(dst + GI_DEC))[tid] = __expf(sB[63 * 129 + tid]);
        }
        __syncthreads();
    }
}
constexpr int GS_BUF = 57344, GS_OFF_ST = 2 * GS_BUF, GS_LDS_BYTES = GS_OFF_ST + 32768;
static __device__ __forceinline__ void phase_gla_seq(char* smem, const Params& P, int bid, int nb, int wv) {
    const int tid = tidx(wv), wid = tid >> 6, lane = tid & 63, fr = lane & 15, fq = lane >> 4;
    bf16_t* MO = (bf16_t*)(P.ws + WS_MO);
    for (int it = bid; it < BATCH * 16; it += nb) {
        const int hf = it & 1, dir = (it >> 1) & 1, head = (it >> 2) & 3, b = it >> 4;
        const char* img0 = P.ws + WS_GIMG + ((size_t)((b * 2 + dir) * NCH) * 4 + head) * GI_BYTES;
        auto stage = [&](int ci, int buf) {
            const char* src = img0 + (size_t)ci * 4 * GI_BYTES; char* dstb = smem + buf * GS_BUF;
#pragma unroll
            for (int i = 0; i < 5; ++i) GLDS16(src + (tid + i * 512) * 16, dstb + (tid + i * 512) * 16);
#pragma unroll
            for (int i = 0; i < 2; ++i) GLDS16(src + GI_VT + hf * 16384 + (tid + i * 512) * 16, dstb + 40960 + (tid + i * 512) * 16);
        };
        for (int e = tid; e < 32768 / 4; e += NTHREADS) ((unsigned*)(smem + GS_OFF_ST))[e] = 0u;
        f32x4 Sacc[8];
#pragma unroll
        for (int n = 0; n < 8; ++n) Sacc[n] = f32x4{0.f, 0.f, 0.f, 0.f};
        WAIT_VM0();
        stage(0, 0);
        float4 dec_nx = *(const float4*)(img0 + GI_DEC + (wid * 16 + fq * 4) * 4);
        WAIT_VM0();
        __syncthreads();
        for (int ci = 0; ci < NCH; ++ci) {
            const char* cur = smem + (ci & 1) * GS_BUF;
            const float4 dec4 = dec_nx;
            if (ci + 1 < NCH) { stage(ci + 1, (ci + 1) & 1); dec_nx = *(const float4*)(img0 + (size_t)(ci + 1) * 4 * GI_BYTES + GI_DEC + (wid * 16 + fq * 4) * 4); }
            const int tt = wid & 3;
            f32x4 oacc[4];
            {
                bf16x8 pf[2], qf[4];
#pragma unroll
                for (int kk = 0; kk < 2; ++kk) pf[kk] = *(const bf16x8*)(cur + 32768 + img128(tt * 16 + fr, kk * 4 + fq));
#pragma unroll
                for (int kk = 0; kk < 4; ++kk) qf[kk] = *(const bf16x8*)(cur + img256(tt * 16 + fr, kk * 4 + fq));
#pragma unroll
                for (int u = 0; u < 4; ++u) {
                    const int et = (wid >> 2) * 4 + u;
                    f32x4 acc = f32x4{0.f, 0.f, 0.f, 0.f};
#pragma unroll
                    for (int kk = 0; kk < 2; ++kk) acc = MFMA16(pf[kk], *(const bf16x8*)(cur + 40960 + img128(et * 16 + fr, kk * 4 + fq)), acc);
#pragma unroll
                    for (int kk = 0; kk < 4; ++kk) acc = MFMA16(qf[kk], *(const bf16x8*)(smem + GS_OFF_ST + img256(et * 16 + fr, kk * 4 + fq)), acc);
                    oacc[u] = acc;
                }
            }
            __syncthreads();
            {
                bf16x8 kf[2];
#pragma unroll
                for (int kk = 0; kk < 2; ++kk) kf[kk] = *(const bf16x8*)(cur + 16384 + img128(wid * 16 + fr, kk * 4 + fq));
#pragma unroll
                for (int n = 0; n < 8; ++n) {
                    f32x4 c = Sacc[n]; c[0] *= dec4.x; c[1] *= dec4.y; c[2] *= dec4.z; c[3] *= dec4.w;
#pragma unroll
                    for (int kk = 0; kk < 2; ++kk) c = MFMA16(kf[kk], *(const bf16x8*)(cur + 40960 + img128(n * 16 + fr, kk * 4 + fq)), c);
                    Sacc[n] = c;
                    *(u32x2*)(smem + GS_OFF_ST + img256(n * 16 + fr, wid * 2 + (fq >> 1)) + (fq & 1) * 8) = u32x2{pack2bf(c[0], c[1]), pack2bf(c[2], c[3])};
                }
            }
            WAIT_VM0();
#pragma unroll
            for (int u = 0; u < 4; ++u) {
                const int et = (wid >> 2) * 4 + u;
#pragma unroll
                for (int q = 0; q < 4; ++q) { const int t = tt * 16 + fq * 4 + q; const int row = vstep_row(b, dir, ci * 64 + t, true); MO[((size_t)dir * NT + row) * D + head * 256 + hf * 128 + et * 16 + fr] = f2bf(oacc[u][q]); }
            }
            __syncthreads();
        }
    }
}

constexpr int RT_MAX_TOK = 320;
constexpr int RW_LD = D + 8;
constexpr int RT_LDS_W = 2 * NE * RW_LD * 2;
static_assert(NE == 32, "router is written for 32 experts");
#ifndef RT_COOP_FROM
#define RT_COOP_FROM 8
#endif
static_assert(RT_LDS_W + (2 * NE + 2 * RT_MAX_TOK * 4) * 4 + (64 + 3 * 64 * 8) * 4 <= 155648 - 16, "router LDS");
static __device__ __forceinline__ void phase_norm2_router(char* smem, const Params& P, int layer, int bid, int nb, int wv) {
    const int tid = tidx(wv), wid = tid >> 6, lane = tid & 63, fr = lane & 15, fq = lane >> 4;
    const bf16_t* sWh = (const bf16_t*)smem; const bf16_t* sWl = sWh + NE * RW_LD;
    int* s_cnt = (int*)(smem + RT_LDS_W); int* s_base = s_cnt + NE; int* s_e = s_base + NE; int* s_rank = s_e + RT_MAX_TOK * 4;
    const bool last = (layer == DEPTH - 1);
    const int r_begin = last ? NT_CTX : 0, n_act = NT - r_begin;
    const int per = (n_act + nb - 1) / nb;
    const int r0 = r_begin + bid * per, r1 = (r0 + per < NT) ? r0 + per : NT;
    {
        const bf16_t* src = (const bf16_t*)(P.ws + WS_RWT) + (size_t)layer * 2 * NE * D;
#pragma unroll
        for (int i = 0; i < 2 * NE * D / 8 / NTHREADS; ++i) { const int c = tid + i * NTHREADS, which = c >> 12, row = (c >> 7) & 31, ch = c & 127;
            *(u32x4*)(smem + (which * NE + row) * RW_LD * 2 + ch * 16) = *(const u32x4*)(src + ((size_t)which * NE + row) * D + ch * 8); }
    }
    if (tid < NE) s_cnt[tid] = 0;
    __syncthreads();
    const bf16_t* H = (const bf16_t*)(P.ws + WS_H); bf16_t* A = (bf16_t*)(P.ws + WS_A);
    const float* gffn = P.in[I_NFFNG] + layer * D + fq * 8; const float* rb = P.in[I_RB] + layer * NE;
    const float rb0 = rb[fr], rb1 = rb[16 + fr];
    const int ntok = r1 - r0;
    auto pass1 = [&](const bf16_t* hrow, int k0, int k1) {
        float ss = 0.f;
#pragma unroll 8
        for (int kk = k0; kk < k1; ++kk) { const u32x4 a = *(const u32x4*)(hrow + kk * 32);
#pragma unroll
            for (int q = 0; q < 4; ++q) { const float x0 = bf2f((bf16_t)(a[q] & 0xffff)), x1 = bf2f((bf16_t)(a[q] >> 16)); ss += x0 * x0 + x1 * x1; } }
        return ss;
    };
    auto pass2 = [&](const bf16_t* hrow, int r, bool tok_ok, float rs, int k0, int k1, f32x4& acc0, f32x4& acc1) {
        const float* sh = modv(P, layer, r, 3) + fq * 8; const float* sc = modv(P, layer, r, 4) + fq * 8;
#pragma unroll 4
        for (int kk = k0; kk < k1; ++kk) {
            const u32x4 hv = *(const u32x4*)(hrow + kk * 32); const float4 ga = *(const float4*)(gffn + kk * 32), gb = *(const float4*)(gffn + kk * 32 + 4);
            const float4 ha = make_float4(bf2f((bf16_t)(hv[0] & 0xffff)), bf2f((bf16_t)(hv[0] >> 16)), bf2f((bf16_t)(hv[1] & 0xffff)), bf2f((bf16_t)(hv[1] >> 16)));
            const float4 hb = make_float4(bf2f((bf16_t)(hv[2] & 0xffff)), bf2f((bf16_t)(hv[2] >> 16)), bf2f((bf16_t)(hv[3] & 0xffff)), bf2f((bf16_t)(hv[3] >> 16)));
            const float4 s1a = *(const float4*)(sh + kk * 32), s1b = *(const float4*)(sh + kk * 32 + 4), s2a = *(const float4*)(sc + kk * 32), s2b = *(const float4*)(sc + kk * 32 + 4);
            float f[8];
            f[0] = ha.x * rs * ga.x * (1.f + s2a.x) + s1a.x; f[1] = ha.y * rs * ga.y * (1.f + s2a.y) + s1a.y; f[2] = ha.z * rs * ga.z * (1.f + s2a.z) + s1a.z; f[3] = ha.w * rs * ga.w * (1.f + s2a.w) + s1a.w;
            f[4] = hb.x * rs * gb.x * (1.f + s2b.x) + s1b.x; f[5] = hb.y * rs * gb.y * (1.f + s2b.y) + s1b.y; f[6] = hb.z * rs * gb.z * (1.f + s2b.z) + s1b.z; f[7] = hb.w * rs * gb.w * (1.f + s2b.w) + s1b.w;
            u32x4 ph, pl;
#pragma unroll
            for (int q = 0; q < 4; ++q) {
                ph[q] = pack2bf(f[2 * q], f[2 * q + 1]);
                pl[q] = pack2bf(f[2 * q] - bf2f((bf16_t)(ph[q] & 0xffff)), f[2 * q + 1] - bf2f((bf16_t)(ph[q] >> 16)));
            }
            if (tok_ok) *(u32x2*)((unsigned char*)A + (size_t)r * D + kk * 32 + fq * 8) = u32x2{pack4f8(f[0] * F8_SA, f[1] * F8_SA, f[2] * F8_SA, f[3] * F8_SA), pack4f8(f[4] * F8_SA, f[5] * F8_SA, f[6] * F8_SA, f[7] * F8_SA)};
            const bf16x8 ah = __builtin_bit_cast(bf16x8, ph), al = __builtin_bit_cast(bf16x8, pl);
            const bf16x8 bh0 = *(const bf16x8*)(sWh + fr * RW_LD + kk * 32 + fq * 8), bh1 = *(const bf16x8*)(sWh + (16 + fr) * RW_LD + kk * 32 + fq * 8);
            const bf16x8 bl0 = *(const bf16x8*)(sWl + fr * RW_LD + kk * 32 + fq * 8), bl1 = *(const bf16x8*)(sWl + (16 + fr) * RW_LD + kk * 32 + fq * 8);
            acc0 = MFMA16(ah, bh0, acc0); acc1 = MFMA16(ah, bh1, acc1);
            acc0 = MFMA16(ah, bl0, acc0); acc1 = MFMA16(ah, bl1, acc1);
            acc0 = MFMA16(al, bh0, acc0); acc1 = MFMA16(al, bh1, acc1);
        }
    };
    auto finish = [&](int g, f32x4 acc0, f32x4 acc1) {
#pragma unroll
        for (int q = 0; q < 4; ++q) {
            float c0 = acc0[q] + rb0, c1 = acc1[q] + rb1;
            float tv[4]; int ti[4];
#pragma unroll
            for (int k = 0; k < 4; ++k) {
                float bv = (c1 > c0) ? c1 : c0; int bi = (c1 > c0) ? 16 + fr : fr;
#pragma unroll
                for (int m = 8; m >= 1; m >>= 1) { const float ov = shx(bv, m, lane); const int oi = shx(bi, m, lane); const bool take = (ov > bv) || (ov == bv && oi < bi); bv = take ? ov : bv; bi = take ? oi : bi; }
                tv[k] = bv; ti[k] = bi;
                if (bi == fr) c0 = -3.0e38f;
                if (bi == 16 + fr) c1 = -3.0e38f;
            }
            const int tl = g * 16 + fq * 4 + q;
            if (fr == 0 && r0 + tl < r1) {
                const float e1 = __expf(tv[1] - tv[0]), e2 = __expf(tv[2] - tv[0]), e3 = __expf(tv[3] - tv[0]); const float inv = rcpf_(1.f + e1 + e2 + e3);
                float* tg = (float*)(P.ws + WS_TOKGATE) + (size_t)(r0 + tl) * 4; int* te = (int*)(P.ws + WS_TOKE) + (size_t)(r0 + tl) * 4;
                tg[0] = inv; tg[1] = e1 * inv; tg[2] = e2 * inv; tg[3] = e3 * inv;
#pragma unroll
                for (int k = 0; k < 4; ++k) { te[k] = ti[k]; s_e[tl * 4 + k] = ti[k]; s_rank[tl * 4 + k] = atomicAdd(&s_cnt[ti[k]], 1); }
            }
        }
    };
    if (wid < RT_COOP_FROM && wid * 16 < ntok) {
        const int g = wid;
        const bool tok_ok = r0 + g * 16 + fr < r1;
        const int r = tok_ok ? r0 + g * 16 + fr : r1 - 1;
        const bf16_t* hrow = H + (size_t)r * D + fq * 8;
        float ss = pass1(hrow, 0, 32);
        ss += shx(ss, 16, lane); ss += shx(ss, 32, lane);
        const float rs = rsqf_(ss * (1.f / D) + 1e-6f);
        f32x4 acc0 = f32x4{0.f, 0.f, 0.f, 0.f}, acc1 = acc0;
        pass2(hrow, r, tok_ok, rs, 0, 32, acc0, acc1);
        finish(g, acc0, acc1);
    }
    {
        float* red_ss = (float*)(smem + RT_LDS_W + (2 * NE + 2 * RT_MAX_TOK * 4) * 4);
        float* red_acc = red_ss + 64;
        for (int g = RT_COOP_FROM; g * 16 < ntok; ++g) {
            const bool tok_ok = r0 + g * 16 + fr < r1;
            const int r = tok_ok ? r0 + g * 16 + fr : r1 - 1;
            const bf16_t* hrow = H + (size_t)r * D + fq * 8;
            if (wid < 4) { float ss = pass1(hrow, wid * 8, wid * 8 + 8); ss += shx(ss, 16, lane); ss += shx(ss, 32, lane); if (fq == 0) red_ss[wid * 16 + fr] = ss; }
            __syncthreads();
            f32x4 acc0 = f32x4{0.f, 0.f, 0.f, 0.f}, acc1 = acc0;
            if (wid < 4) {
                const float rs = rsqf_((red_ss[fr] + red_ss[16 + fr] + red_ss[32 + fr] + red_ss[48 + fr]) * (1.f / D) + 1e-6f);
                pass2(hrow, r, tok_ok, rs, wid * 8, wid * 8 + 8, acc0, acc1);
                if (wid > 0) { *(f32x4*)(red_acc + ((wid - 1) * 64 + lane) * 8) = acc0; *(f32x4*)(red_acc + ((wid - 1) * 64 + lane) * 8 + 4) = acc1; }
            }
            __syncthreads();
            if (wid == 0) {
#pragma unroll
                for (int w = 0; w < 3; ++w) { acc0 += *(const f32x4*)(red_acc + (w * 64 + lane) * 8); acc1 += *(const f32x4*)(red_acc + (w * 64 + lane) * 8 + 4); }
                finish(g, acc0, acc1);
            }
            __syncthreads();
        }
    }
    __syncthreads();
    if (tid < NE) s_base[tid] = (int)atomicAdd((unsigned*)(P.ws + WS_CNT) + layer * NE + tid, (unsigned)s_cnt[tid]);
    __syncthreads();
    int* RT = (int*)(P.ws + WS_ROWTOK); int* TP = (int*)(P.ws + WS_TOKPOS);
    for (int q = tid; q < (r1 - r0) * 4; q += NTHREADS) {
        const int tl = q >> 2, r = r0 + tl, e = s_e[q], pos = s_base[e] + s_rank[q];
        RT[(size_t)e * NT + pos] = r; TP[(size_t)r * 4 + (q & 3)] = pos;
    }
}

static __device__ __forceinline__ void phase_moe_gu(char* smem, const Params& P, int layer, int bid, int nb, int wv) {
    int* s_off = (int*)(smem + GEMM2_LDS); int* s_rbe = s_off + 64; const int* s_cnt = s_rbe + MOE_RBE_MAX; unsigned* s_rt = (unsigned*)(smem + GEMM2_LDS + 4096);
    const unsigned* counts = (const unsigned*)(P.ws + WS_CNT) + layer * NE;
    moe_offsets(wv, counts, s_off, s_rbe);
    const int nrb = s_off[NE] / MOE_BM;
    const bf16_t* A = (const bf16_t*)(P.ws + WS_A); const int* RT = (const int*)(P.ws + WS_ROWTOK);
    bf16_t* HDN = (bf16_t*)(P.ws + WS_HDN);
    const int xg = bid & 7, slot = bid >> 3, spx = nb >> 3;
    auto issue_rt = [&](int t, int buf) {
        const int rbg = xg + 8 * (t >> 3);
        if (rbg < nrb && wv < 4) { const int e = uni(s_rbe[rbg]), rb = rbg - s_off[e] / MOE_BM, r = tidx(wv) & 255; GLDS4(RT + (size_t)e * NT + rb * MOE_BM + r, s_rt + buf * 256 + r); }
    };
    issue_rt(slot, 0); WAIT_VM0(); __syncthreads();
    int it = 0;
    for (int t = slot;; t += spx, ++it) {
        const int rbg = xg + 8 * (t >> 3), cb = t & 7;
        if (rbg >= nrb) break;
        const int e = uni(s_rbe[rbg]);
        const int rb = rbg - s_off[e] / MOE_BM, cnt = s_cnt[e];
        const bf16_t* Bt = (const bf16_t*)(P.ws + WS_WGU) + ((size_t)(layer * NE + e) * 2 * D + cb * 256) * (D / 2);
        const float* bgu = P.in[I_BGU] + (size_t)(layer * NE + e) * 2 * D;
        const unsigned* rt = s_rt + (it & 1) * 256;
        gemm_tile256<true>(wv, smem, A, [&](int r) { const unsigned tok = (rb * MOE_BM + r < cnt) ? rt[r] : 0u; return tok * (unsigned)(D / 2); }, Bt, D / 2, D / 2,
                  [&](f32x4 (&acc)[2][2][4][2], int wr, int wc, int fr, int fq) {
#pragma unroll
                      for (int bj = 0; bj < 2; ++bj) {
                          const int jh = (cb * 8 + bj * 4 + wc) * 16 + fq * 4;
                          const float4 b0 = *(const float4*)(bgu + 2 * jh), b1 = *(const float4*)(bgu + 2 * jh + 4);
                          const float bg[4] = {b0.x, b0.z, b1.x, b1.z}, bu[4] = {b0.y, b0.w, b1.y, b1.w};
#pragma unroll
                          for (int ai = 0; ai < 2; ++ai)
#pragma unroll
                              for (int m = 0; m < 4; ++m) {
                                  float hv[4];
#pragma unroll
                                  for (int q = 0; q < 4; ++q) {
                                      const float g = fminf(acc[ai][bj][m][0][q] * (1.f / (F8_SA * F8_SW)) + bg[q], 7.f), u = fminf(fmaxf(acc[ai][bj][m][1][q] * (1.f / (F8_SA * F8_SW)) + bu[q], -7.f), 7.f);
                                      hv[q] = (u + 1.f) * (g * sigmoidf_(1.702f * g));
                                  }
                                  *(unsigned*)((unsigned char*)HDN + (size_t)(rbg * MOE_BM + ai * 128 + wr * 64 + m * 16 + fr) * D + jh) = pack4f8(hv[0] * F8_SH, hv[1] * F8_SH, hv[2] * F8_SH, hv[3] * F8_SH);
                              }
                      }
                  },
                  [&]() { issue_rt(t + spx, (it + 1) & 1); });
    }
}
static __device__ __forceinline__ void phase_moe_down(char* smem, const Params& P, int layer, int bid, int nb, int wv) {
    int* s_off = (int*)(smem + GEMM2_LDS);
    const unsigned* counts = (const unsigned*)(P.ws + WS_CNT) + layer * NE;
    int* s_rbe = s_off + 64;
    moe_offsets(wv, counts, s_off, s_rbe);
    const int nrb = s_off[NE] / MOE_BM;
    const bf16_t* HDN = (const bf16_t*)(P.ws + WS_HDN); bf16_t* YB = (bf16_t*)(P.ws + WS_YB);
    const int xg = bid & 7, slot = bid >> 3, spx = nb >> 3;
    for (int t = slot;; t += spx) {
        const int rbg = xg + 8 * (t >> 2), cb = t & 3;
        if (rbg >= nrb) break;
        const int e = uni(s_rbe[rbg]);
        const bf16_t* Bt = (const bf16_t*)(P.ws + WS_WDN) + ((size_t)(layer * NE + e) * D + cb * 256) * (D / 2);
        const float* bd = P.in[I_BDN] + (size_t)(layer * NE + e) * D + cb * 256;
        gemm_tile256<true>(wv, smem, HDN, [&](int r) { return (unsigned)(rbg * MOE_BM + r) * (unsigned)(D / 2); }, Bt, D / 2, D / 2,
                  [&](f32x4 (&acc)[2][2][4][2], int wr, int wc, int fr, int fq) {
                      epi256_vec4(acc, wr, wc, fr, fq, [&](int r, int c, f32x4 v) { const float4 bb = *(const float4*)(bd + c); const float sc = F8_SY / (F8_SH * F8_SW); *(unsigned*)((unsigned char*)YB + (size_t)(rbg * MOE_BM + r) * D + cb * 256 + c) = pack4f8(v[0] * sc + bb.x * F8_SY, v[1] * sc + bb.y * F8_SY, v[2] * sc + bb.z * F8_SY, v[3] * sc + bb.w * F8_SY); });
                  });
    }
}

static __device__ __forceinline__ void phase_final(char* smem, const Params& P, int bid, int nb, int wv) {
    int* s_off = (int*)smem;
    moe_offsets(wv, (const unsigned*)(P.ws + WS_CNT) + (DEPTH - 1) * NE, s_off);
    const int wid = tidx(wv) >> 6, lane = tidx(wv) & 63;
    const bf16_t* H = (const bf16_t*)(P.ws + WS_H); const bf16_t* YB = (const bf16_t*)(P.ws + WS_YB); const float* fg = P.in[I_FNORM];
    for (int r = NT_CTX + bid * 8 + wid; r < NT; r += nb * 8) {
        float v[16], mo[16];
#pragma unroll
        for (int i = 0; i < 4; ++i) { const u32x2 t = *(const u32x2*)(H + (size_t)r * D + 256 * i + 4 * lane); v[4 * i] = bf2f((bf16_t)(t[0] & 0xffff)); v[4 * i + 1] = bf2f((bf16_t)(t[0] >> 16)); v[4 * i + 2] = bf2f((bf16_t)(t[1] & 0xffff)); v[4 * i + 3] = bf2f((bf16_t)(t[1] >> 16)); }
        const int* te = (const int*)(P.ws + WS_TOKE) + r * 4; const int* tp = (const int*)(P.ws + WS_TOKPOS) + r * 4; const float* tg = (const float*)(P.ws + WS_TOKGATE) + r * 4;
        const float* g2 = modv(P, DEPTH - 1, r, 5);
#pragma unroll
        for (int i = 0; i < 16; ++i) mo[i] = 0.f;
#pragma unroll
        for (int k = 0; k < 4; ++k) {
            const size_t row = (size_t)(s_off[te[k]] + tp[k]); const float g = tg[k] * (1.f / F8_SY);
#pragma unroll
            for (int i = 0; i < 4; ++i) { float y[4]; unpack4f8(*(const unsigned*)((const unsigned char*)YB + row * D + 256 * i + 4 * lane), y);
                mo[4 * i] += g * y[0]; mo[4 * i + 1] += g * y[1]; mo[4 * i + 2] += g * y[2]; mo[4 * i + 3] += g * y[3]; }
        }
#pragma unroll
        for (int i = 0; i < 4; ++i) { const float4 t = *(const float4*)(g2 + 256 * i + 4 * lane); v[4 * i] += t.x * mo[4 * i]; v[4 * i + 1] += t.y * mo[4 * i + 1]; v[4 * i + 2] += t.z * mo[4 * i + 2]; v[4 * i + 3] += t.w * mo[4 * i + 3]; }
        float ss = 0.f;
#pragma unroll
        for (int i = 0; i < 16; ++i) ss += v[i] * v[i];
        ss = wave_sum(ss, lane);
        const float rs = rsqf_(ss * (1.f / D) + 1e-6f);
#pragma unroll
        for (int i = 0; i < 4; ++i) { const int c = 256 * i + 4 * lane; const float4 g = *(const float4*)(fg + c);
            *(float4*)(P.out + (size_t)(r - NT_CTX) * D + c) = make_float4(v[4 * i] * rs * g.x, v[4 * i + 1] * rs * g.y, v[4 * i + 2] * rs * g.z, v[4 * i + 3] * rs * g.w); }
    }
}

static __device__ __forceinline__ void phase_inproj_even(char* smem, const Params& P, int j, int bid, int nb, int wv) {
    bf16_t* Z = (bf16_t*)(P.ws + WS_Z); float* G = (float*)(P.ws + WS_GATES); const float* bin = P.in[I_EVBIN] + (size_t)j * P_EVEN;
    phase_gemm_dense(smem, (const bf16_t*)(P.ws + WS_A), D, (const bf16_t*)(P.ws + WS_WEVIN) + (size_t)j * P_EVEN_PAD * D, D, NT, P_EVEN_PAD, bid, nb, wv,
        [&](f32x4 (&acc)[2][2][4][2], int wr, int wc, int fr, int fq, int row0, int col0) {
            epi256_vec4(acc, wr, wc, fr, fq, [&](int r, int c, f32x4 v) {
                const int col = col0 + c, row = row0 + r;
                if (col < P_EVEN) {
                    const float4 bb = *(const float4*)(bin + col); v[0] += bb.x; v[1] += bb.y; v[2] += bb.z; v[3] += bb.w;
                    if (col >= 2048 && col < 2064) *(float4*)(G + (size_t)row * 32 + col - 2048) = make_float4(v[0], v[1], v[2], v[3]);
                    else *(u32x2*)(Z + (size_t)row * ZLD + col) = u32x2{pack2bf(v[0], v[1]), pack2bf(v[2], v[3])};
                }
            });
        });
}
static __device__ __forceinline__ void phase_inproj_odd(char* smem, const Params& P, int j, int bid, int nb, int wv) {
    bf16_t* Z = (bf16_t*)(P.ws + WS_Z); float* G = (float*)(P.ws + WS_GATES);
    phase_gemm_dense(smem, (const bf16_t*)(P.ws + WS_A), D, (const bf16_t*)(P.ws + WS_WODIN) + (size_t)j * P_ODD_PAD * D, D, NT, P_ODD_PAD, bid, nb, wv,
        [&](f32x4 (&acc)[2][2][4][2], int wr, int wc, int fr, int fq, int row0, int col0) {
            epi256_vec4(acc, wr, wc, fr, fq, [&](int r, int c, f32x4 v) {
                const int col = col0 + c, row = row0 + r;
                if (col < 3072) *(u32x2*)(Z + (size_t)row * ZLD + col) = u32x2{pack2bf(v[0], v[1]), pack2bf(v[2], v[3])};
                else if (col < P_ODD) *(float4*)(G + (size_t)row * 32 + col - 3072) = make_float4(v[0], v[1], v[2], v[3]);
            });
        });
}
static __device__ __forceinline__ void phase_glu(char* smem, const Params& P, int j, int bid, int nb, int wv) {
    const bf16_t* YY = (const bf16_t*)(P.ws + WS_YY); bf16_t* CAT = (bf16_t*)(P.ws + WS_CAT); const float* gb = P.in[I_GLUB] + (size_t)j * 512;
    phase_gemm_dense(smem, YY, 512, (const bf16_t*)(P.ws + WS_WGLU) + (size_t)j * 512 * 512, 512, NT, 512, bid, nb, wv,
        [&](f32x4 (&acc)[2][2][4][2], int wr, int wc, int fr, int fq, int row0, int col0) {
            epi256_vec4(acc, wr, wc, fr, fq, [&](int r, int c, f32x4 v) {
                const int col = col0 + c, row = row0 + r; const u32x2 yv = *(const u32x2*)(YY + (size_t)row * 512 + col); const float4 bb = *(const float4*)(gb + col);
                const float y0 = bf2f((bf16_t)(yv[0] & 0xffff)), y1 = bf2f((bf16_t)(yv[0] >> 16)), y2 = bf2f((bf16_t)(yv[1] & 0xffff)), y3 = bf2f((bf16_t)(yv[1] >> 16));
                *(u32x2*)(CAT + (size_t)row * D + 512 + col) = u32x2{pack2bf(y0 * sigmoidf_(v[0] + bb.x), y1 * sigmoidf_(v[1] + bb.y)), pack2bf(y2 * sigmoidf_(v[2] + bb.z), y3 * sigmoidf_(v[3] + bb.w))};
            });
        });
}
static __device__ __forceinline__ void phase_outproj(char* smem, const Params& P, int layer, const bf16_t* Wt, int bid, int nb, int wv) {
    bf16_t* H = (bf16_t*)(P.ws + WS_H);
    phase_gemm_dense(smem, (const bf16_t*)(P.ws + WS_CAT), D, Wt, D, NT, D, bid, nb, wv,
        [&](f32x4 (&acc)[2][2][4][2], int wr, int wc, int fr, int fq, int row0, int col0) {
            epi256_vec4(acc, wr, wc, fr, fq, [&](int r, int c, f32x4 v) {
                const int col = col0 + c, row = row0 + r; const float4 g = *(const float4*)(modv(P, layer, row, 2) + col);
                u32x2* hp = (u32x2*)(H + (size_t)row * D + col); const u32x2 h = *hp;
                *hp = u32x2{pack2bf(bf2f((bf16_t)(h[0] & 0xffff)) + g.x * v[0], bf2f((bf16_t)(h[0] >> 16)) + g.y * v[1]), pack2bf(bf2f((bf16_t)(h[1] & 0xffff)) + g.z * v[2], bf2f((bf16_t)(h[1] >> 16)) + g.w * v[3])};
            });
        });
}

constexpr int LDS_BYTES = 155648;
static_assert(GP_LDS_BYTES <= LDS_BYTES - 16 && GS_LDS_BYTES <= LDS_BYTES - 16 && GL_LDS_BYTES <= LDS_BYTES && S5_LDS_BYTES <= LDS_BYTES && ML_LDS_BYTES <= LDS_BYTES && GEMM_LDS + 256 <= LDS_BYTES && GEMM2_LDS + 256 <= LDS_BYTES, "LDS budget");
static_assert((BATCH + 1) * D * 4 + 8 * (BATCH + 1) * 64 * 4 <= LDS_BYTES, "modvec LDS");

#define KDEF(name, body) __global__ void __launch_bounds__(NTHREADS, 2) name(Params P, int a0, int a1) { SMEM_DECL; (void)a0; (void)a1; const int bid = blockIdx.x, nb = gridDim.x, wv = (int)(threadIdx.x >> 6); body; }
#if !MULTI_LAUNCH
KDEF(k_s5, phase_s5(smem, P, a0, bid, nb, wv))
#endif
#if MULTI_LAUNCH
#define KDEF_UNUSED(name, body) __global__ void __launch_bounds__(NTHREADS, 2) name(Params P, int a0, int a1) { SMEM_DECL; (void)a0; (void)a1; const int bid = blockIdx.x, nb = gridDim.x, wv = (int)(threadIdx.x >> 6); body; }
KDEF(k_prologue, phase_prologue(smem, P, bid, nb, wv))
KDEF(k_norm1, phase_norm1(smem, P, a0, bid, nb, wv))
KDEF(k_inproj_even, phase_inproj_even(smem, P, a0, bid, nb, wv))
KDEF(k_inproj_odd, phase_inproj_odd(smem, P, a0, bid, nb, wv))
KDEF(k_conv, phase_conv(P, a0, bid, nb, wv))
KDEF(k_mlstm, phase_mlstm(smem, P, bid, nb, wv))
KDEF(k_s5, phase_s5(smem, P, a0, bid, nb, wv))
KDEF(k_post_even, phase_post_even(P, a0, bid, nb, wv))
KDEF(k_glu, phase_glu(smem, P, a0, bid, nb, wv))
KDEF(k_outproj_even, phase_outproj(smem, P, a0, (const bf16_t*)(P.ws + WS_WEVOUT) + (size_t)a1 * D * D, bid, nb, wv))
KDEF(k_outproj_odd, phase_outproj(smem, P, a0, (const bf16_t*)(P.ws + WS_WODOUT) + (size_t)a1 * D * D, bid, nb, wv))
KDEF(k_gla_prep, phase_gla_prep(smem, P, a0, bid, nb, wv))
KDEF(k_gla_seq, phase_gla_seq(smem, P, bid, nb, wv))
KDEF(k_post_odd, phase_post_odd(P, a0, bid, nb, wv))
KDEF(k_norm2_router, phase_norm2_router(smem, P, a0, bid, nb, wv))
KDEF(k_moe_gu, phase_moe_gu(smem, P, a0, bid, nb, wv))
KDEF(k_moe_down, phase_moe_down(smem, P, a0, bid, nb, wv))
KDEF(k_final, phase_final(smem, P, bid, nb, wv))
#endif


#if !MULTI_LAUNCH
#define XB_TMO      128
#define XB_XCNT(j)  (256  + 64 * (j))
#define XB_XSUB(j)  (1280 + 64 * (j))
#define XB_XGEN(j)  (2304 + 64 * (j))
#define XB_TOP      3328
#define XB_TOPGEN   3392
#define XCD_BAR_WORDS 3456
#define XB_SPIN_CAP (1u << 18)
#define LAS __attribute__((address_space(3)))
static_assert(XCD_BAR_WORDS == XCD_BAR_WORDS_C, "barrier words");
__device__ __forceinline__ unsigned xb_ld(unsigned* p)              { return __hip_atomic_load(p, __ATOMIC_RELAXED, __HIP_MEMORY_SCOPE_AGENT); }
__device__ __forceinline__ unsigned xb_add(unsigned* p, unsigned v) { return __hip_atomic_fetch_add(p, v, __ATOMIC_RELAXED, __HIP_MEMORY_SCOPE_AGENT); }
__device__ __forceinline__ unsigned xb_xcc_id() { return (unsigned)__builtin_amdgcn_s_getreg((3 << 11) | 20) & 0xFu; }
#define XB_SPIN(cond, bar) do { unsigned _sp = 0; while (cond) { __builtin_amdgcn_s_sleep(1); \
    if ((++_sp & 255u) == 0u) { if (xb_ld(&(bar)[XB_TMO])) break; if (_sp > XB_SPIN_CAP) { atomicAdd(&(bar)[XB_TMO], 1u); break; } } } } while (0)
struct XcdBarrier { unsigned* bar; unsigned x; volatile LAS unsigned* st; };
__device__ __forceinline__ XcdBarrier xcd_barrier_post(unsigned* bar, volatile LAS unsigned* st) {
    XcdBarrier b; b.bar = bar; b.x = xb_xcc_id(); b.st = st;
    if (threadIdx.x == 0) (void)xb_add(&bar[XB_XCNT(b.x)], 1u);
    return b;
}
__device__ __forceinline__ void xcd_barrier_complete(unsigned* bar, unsigned x, unsigned& nloc, unsigned& nx) {
    const unsigned G = gridDim.x * gridDim.y * gridDim.z;
    unsigned sum, cnt, mine, sp = 0u;
    for (;;) {
        sum = 0u; cnt = 0u; mine = 0u;
#pragma unroll
        for (unsigned j = 0; j < 16; ++j) { const unsigned c = xb_ld(&bar[XB_XCNT(j)]); sum += c; cnt += (c > 0u) ? 1u : 0u; }
        if (sum == G) { mine = xb_ld(&bar[XB_XCNT(x)]); break; }
        __builtin_amdgcn_s_sleep(1);
        if ((++sp & 255u) == 0u) { if (xb_ld(&bar[XB_TMO])) break; if (sp > XB_SPIN_CAP) { atomicAdd(&bar[XB_TMO], 1u); break; } }
    }
    nloc = mine > 0u ? mine : 1u; nx = cnt > 0u ? cnt : 1u;
}
__device__ __forceinline__ void xcd_barrier(const XcdBarrier& b) {
    asm volatile("s_waitcnt vmcnt(0)" ::: "memory");
    __syncthreads();
    if (threadIdx.x == 0) {
        unsigned* bar = b.bar;
        __builtin_amdgcn_s_waitcnt(0);
        unsigned nloc = b.st[0], nx = b.st[1];
        if (nloc == 0u) { xcd_barrier_complete(bar, b.x, nloc, nx); b.st[0] = nloc; b.st[1] = nx; }
        const unsigned old = xb_add(&bar[XB_XSUB(b.x)], 1u);
        const unsigned gen = old / nloc;
        if (old + 1u == (gen + 1u) * nloc) {
            __builtin_amdgcn_fence(__ATOMIC_RELEASE, "agent");
            asm volatile("s_waitcnt vmcnt(0)" ::: "memory");
            const unsigned og = xb_add(&bar[XB_TOP], 1u);
            const unsigned tg = og / nx;
            if (og + 1u == (tg + 1u) * nx) xb_add(&bar[XB_TOPGEN], 1u);
            else XB_SPIN(xb_ld(&bar[XB_TOPGEN]) == tg, bar);
            __builtin_amdgcn_fence(__ATOMIC_ACQUIRE, "agent");
            xb_add(&bar[XB_XGEN(b.x)], 1u);
            asm volatile("s_waitcnt vmcnt(0)" ::: "memory");
        } else {
            XB_SPIN(xb_ld(&bar[XB_XGEN(b.x)]) == gen, bar);
            __builtin_amdgcn_fence(__ATOMIC_ACQUIRE, "agent");
            asm volatile("s_waitcnt vmcnt(0)" ::: "memory");
        }
    }
    __syncthreads();
}

__device__ __forceinline__ Params load_params() {
#if defined(__HIP_DEVICE_COMPILE__)
    const __attribute__((address_space(4))) Params* kp = (const __attribute__((address_space(4))) Params*)__builtin_amdgcn_kernarg_segment_ptr();
    asm volatile("" : "+s"(kp));
    Params r;
#pragma unroll
    for (int i = 0; i < N_INPUTS; ++i) r.in[i] = kp->in[i];
    r.out = kp->out; r.ws = kp->ws;
    return r;
#else
    return Params{};
#endif
}
__global__ void __launch_bounds__(NTHREADS, 2) k_mega(Params P, int ph_begin, int ph_end, int bar_slot) {
    SMEM_DECL;
    volatile LAS unsigned* st = (volatile LAS unsigned*)(smem + LDS_BYTES - 16);
    if (threadIdx.x == 0) { st[0] = 0u; st[1] = 0u; st[2] = 0u; st[3] = 0u; }
    __syncthreads();
    const XcdBarrier bar = xcd_barrier_post((unsigned*)(P.ws + WS_BAR) + (size_t)bar_slot * XCD_BAR_WORDS, st);
    const int nb = gridDim.x;
    const int wv = __builtin_amdgcn_readfirstlane((int)(threadIdx.x >> 6));
    int pc = 0;
#define PH(call) do { if (pc >= ph_begin && pc < ph_end) { const Params P = load_params(); int bid = blockIdx.x; asm volatile("" : "+s"(bid)); call; if (pc + 1 < ph_end) xcd_barrier(bar); } ++pc; } while (0)
#ifndef TIMING_DUP
#define TIMING_DUP 0
#endif
#define PHD(bit, call) do { PH(call); if ((TIMING_DUP >> (bit)) & 1) { PH(call); } } while (0)
    PHD(0, phase_prologue(smem, P, bid, nb, wv));
#pragma unroll 1
    for (int layer = 0; layer < DEPTH; ++layer) {
        const int j = layer >> 1;
        PH(phase_norm1(smem, P, layer, bid, nb, wv));
        if ((layer & 1) == 0) {
            PHD(1, phase_inproj_even(smem, P, j, bid, nb, wv));
            PHD(2, phase_conv(P, j, bid, nb, wv));
            PHD(3, (bid < (nb >> 1)) ? phase_mlstm(smem, P, bid, nb >> 1, wv) : phase_s5(smem, P, j, bid - (nb >> 1), nb - (nb >> 1), wv));
            PHD(5, phase_post_even(P, j, bid, nb, wv));
            PHD(6, phase_glu(smem, P, j, bid, nb, wv));
        } else {
            PHD(1, phase_inproj_odd(smem, P, j, bid, nb, wv));
            PHD(7, phase_gla_prep(smem, P, j, bid, nb, wv));
            PHD(13, phase_gla_seq(smem, P, bid, nb, wv));
            PHD(5, phase_post_odd(P, j, bid, nb, wv));
        }
        PH(phase_outproj(smem, P, layer, (const bf16_t*)(P.ws + ((layer & 1) ? WS_WODOUT : WS_WEVOUT)) + (size_t)j * D * D, bid, nb, wv));
        PH(phase_norm2_router(smem, P, layer, bid, nb, wv));
        PHD(8, phase_moe_gu(smem, P, layer, bid, nb, wv));
        PHD(9, phase_moe_down(smem, P, layer, bid, nb, wv));
    }
    PH(phase_final(smem, P, bid, nb, wv));
}
#endif

#ifdef HOST_EMU
#ifndef EMU_GRID
#define EMU_GRID 16
#endif
static const int kGrid = EMU_GRID;
int g_stop_after = 1000;
void emu_hook(int step, const char* name, const Params& p);
#define RUN(k, a0, a1) do { if (step < g_stop_after) { LAUNCH(k, kGrid, NTHREADS, LDS_BYTES, stream, p, a0, a1); emu_hook(step, #k, p); } ++step; } while (0)
#else
static const int kGrid = 256;
#define RUN(k, a0, a1) do { ++step; LAUNCH(k, kGrid, NTHREADS, LDS_BYTES, stream, p, a0, a1); } while (0)
#endif

extern "C" void kernel_launch(void* const* d_in, const int* in_sizes, int n_in, void* d_out, int out_size, void* d_ws, size_t ws_size, hipStream_t stream) {
    (void)in_sizes; (void)n_in; (void)out_size;
    if (ws_size < WS_TOTAL) { fprintf(stderr, "kernel_launch: workspace too small (%zu < %zu)\n", ws_size, (size_t)WS_TOTAL); return; }
    Params p{};
    for (int i = 0; i < N_INPUTS; ++i) p.in[i] = (const float*)d_in[i];
    p.out = (float*)d_out; p.ws = (char*)d_ws;
    (void)hipMemsetAsync(d_ws, 0, WS_ZERO_BYTES, stream);
    int step = 0;
#if MULTI_LAUNCH
#ifndef HOST_EMU
    static bool attr_done = false;
    if (!attr_done) {
        attr_done = true;
        const void* ks[] = {(const void*)k_prologue, (const void*)k_norm1, (const void*)k_inproj_even, (const void*)k_inproj_odd, (const void*)k_conv, (const void*)k_mlstm, (const void*)k_s5,
                            (const void*)k_post_even, (const void*)k_glu, (const void*)k_outproj_even, (const void*)k_outproj_odd, (const void*)k_gla_prep, (const void*)k_gla_seq, (const void*)k_post_odd,
                            (const void*)k_norm2_router, (const void*)k_moe_gu, (const void*)k_moe_down, (const void*)k_final};
        for (const void* k : ks) if (hipFuncSetAttribute(k, hipFuncAttributeMaxDynamicSharedMemorySize, LDS_BYTES) != hipSuccess) fprintf(stderr, "kernel_launch: hipFuncSetAttribute failed\n");
    }
#endif
    RUN(k_prologue, 0, 0);
    for (int layer = 0; layer < DEPTH; ++layer) {
        const int j = layer / 2;
        RUN(k_norm1, layer, 0);
        if ((layer & 1) == 0) {
            RUN(k_inproj_even, j, 0);
            RUN(k_conv, j, 0);
            RUN(k_mlstm, 0, 0);
            RUN(k_s5, j, 0);
            RUN(k_post_even, j, 0);
            RUN(k_glu, j, 0);
            RUN(k_outproj_even, layer, j);
        } else {
            RUN(k_inproj_odd, j, 0);
            RUN(k_gla_prep, j, 0);
            RUN(k_gla_seq, 0, 0);
            RUN(k_post_odd, j, 0);
            RUN(k_outproj_odd, layer, j);
        }
        RUN(k_norm2_router, layer, 0);
        RUN(k_moe_gu, layer, 0);
        RUN(k_moe_down, layer, 0);
    }
    RUN(k_final, 0, 0);
#else
    static int grid = 0;
    if (!grid) {
        int dev = 0, cus = 0, per_cu = 0;
        (void)hipGetDevice(&dev);
        (void)hipDeviceGetAttribute(&cus, hipDeviceAttributeMultiprocessorCount, dev);
        if (hipFuncSetAttribute((const void*)k_mega, hipFuncAttributeMaxDynamicSharedMemorySize, LDS_BYTES) != hipSuccess) fprintf(stderr, "kernel_launch: hipFuncSetAttribute failed\n");
        if (hipOccupancyMaxActiveBlocksPerMultiprocessor(&per_cu, (const void*)k_mega, NTHREADS, LDS_BYTES) != hipSuccess || per_cu < 1) fprintf(stderr, "kernel_launch: occupancy query says %d blocks per CU\n", per_cu);
        grid = cus > 0 ? cus : 256;
    }
    (void)step;
    hipLaunchKernelGGL(k_mega, dim3(grid), dim3(NTHREADS), LDS_BYTES, stream, p, 0, 1000, 0);

#endif
}
```

```cpp
#ifndef HOST_EMU
#include <hip/hip_runtime.h>
#endif
#include <cstdio>
#include <cstdint>

#ifndef CFG_B
#define CFG_B 16
#endif
#ifndef CFG_SEQ
#define CFG_SEQ 2048
#endif
#ifndef CFG_CTX
#define CFG_CTX 256
#endif
#ifndef CFG_DEPTH
#define CFG_DEPTH 4
#endif
#ifndef CFG_NE
#define CFG_NE 32
#endif
#ifdef HOST_EMU
#undef MULTI_LAUNCH
#define MULTI_LAUNCH 1
#endif
#ifndef MULTI_LAUNCH
#define MULTI_LAUNCH 0
#endif

constexpr int D = 1024, BATCH = CFG_B, SEQ = CFG_SEQ, CTXL = CFG_CTX, DEPTH = CFG_DEPTH, NE = CFG_NE, TOPK = 4;
constexpr int N_EVEN = (DEPTH + 1) / 2, N_ODD = DEPTH / 2;
constexpr int NT_CTX = BATCH * CTXL, NT_LAT = BATCH * SEQ, NT = NT_CTX + NT_LAT;
constexpr int GRID_W = 64, GROWS = SEQ / GRID_W;
constexpr int P_EVEN = 2576, P_EVEN_PAD = 2816, P_ODD = 3104, P_ODD_PAD = 3328, ZLD = 3200;
constexpr int NCH_CTX = CTXL / 64, NCH_LAT = SEQ / 64, NCH = NCH_CTX + NCH_LAT;
constexpr int MOE_BM = 256;
constexpr int ROWS_MAX = NT * TOPK + NE * MOE_BM;
constexpr int NTHREADS = 512;
static_assert(NT % 256 == 0, "token count must be a multiple of 256");
static_assert(SEQ % 64 == 0 && CTXL % 64 == 0, "chunking");

typedef unsigned short bf16_t;
#ifndef HOST_EMU
typedef short bf16x8 __attribute__((ext_vector_type(8)));
typedef float f32x4 __attribute__((ext_vector_type(4)));
typedef float f32x16 __attribute__((ext_vector_type(16)));
#endif
typedef unsigned u32x4 __attribute__((ext_vector_type(4)));
typedef unsigned u32x2 __attribute__((ext_vector_type(2)));
typedef int i32x4 __attribute__((ext_vector_type(4)));
typedef int i32x8 __attribute__((ext_vector_type(8)));

#ifdef HOST_EMU
#define MFMA16(a, b, c) emu_mfma_16x16x32_bf16(a, b, c)
#define MFMA32(a, b, c) emu_mfma_32x32x16_bf16(a, b, c)
#define MFMA128F8(a, b, c) emu_mfma_16x16x128_fp8(a, b, c)
#define GLDS16(g, l) emu_glds16((const void*)(g), (void*)(l))
#define GLDS4(g, l) emu_glds4((const void*)(g), (void*)(l))
#define WAIT_VM0() do {} while (0)
#define SMEM_DECL char* smem = emu::g_smem
#define LAUNCH(kern, grid, block, lds, stream, ...) emu::launch(grid, block, lds, [=]() { kern(__VA_ARGS__); })
#else
#define LDSAS __attribute__((address_space(3)))
#define MFMA16(a, b, c) __builtin_amdgcn_mfma_f32_16x16x32_bf16(a, b, c, 0, 0, 0)
#define MFMA32(a, b, c) __builtin_amdgcn_mfma_f32_32x32x16_bf16(a, b, c, 0, 0, 0)
#define MFMA128F8(a, b, c) __builtin_amdgcn_mfma_scale_f32_16x16x128_f8f6f4(a, b, c, 0, 0, 0, 0, 0, 0)
#define GLDS16(g, l) __builtin_amdgcn_global_load_lds((const unsigned*)(g), (LDSAS unsigned*)(l), 16, 0, 0)
#define GLDS4(g, l) __builtin_amdgcn_global_load_lds((const unsigned*)(g), (LDSAS unsigned*)(l), 4, 0, 0)
#define WAIT_VM0() asm volatile("s_waitcnt vmcnt(0)" ::: "memory")
#define SMEM_DECL extern __shared__ __attribute__((aligned(256))) char smem[]
#define LAUNCH(kern, grid, block, lds, stream, ...) hipLaunchKernelGGL(kern, dim3(grid), dim3(block), lds, stream, __VA_ARGS__)
#endif

#ifdef HOST_EMU
__device__ __forceinline__ int tidx(int wv) { (void)wv; return (int)threadIdx.x; }
#else
__device__ __forceinline__ int tidx(int wv) { int l; asm volatile("v_mbcnt_lo_u32_b32 %0, -1, 0\n\tv_mbcnt_hi_u32_b32 %0, -1, %0" : "=v"(l)); return (wv << 6) | l; }
#endif
#ifdef HOST_EMU
__device__ __forceinline__ int uni(int v) { return v; }
#else
__device__ __forceinline__ int uni(int v) { return __builtin_amdgcn_readfirstlane(v); }
#endif
__device__ __forceinline__ float bf2f(bf16_t v) { unsigned u = ((unsigned)v) << 16; return __builtin_bit_cast(float, u); }
#ifdef HOST_EMU
__device__ __forceinline__ bf16_t f2bf(float f) { unsigned u = __builtin_bit_cast(unsigned, f); u += 0x7fffu + ((u >> 16) & 1u); return (bf16_t)(u >> 16); }
#else
__device__ __forceinline__ bf16_t f2bf(float f) { return __builtin_bit_cast(unsigned short, (__bf16)f); }
#endif
#ifdef HOST_EMU
__device__ __forceinline__ unsigned pack2bf(float lo, float hi) { return (unsigned)f2bf(lo) | ((unsigned)f2bf(hi) << 16); }
#else
typedef __bf16 hwbf16x2 __attribute__((ext_vector_type(2)));
__device__ __forceinline__ unsigned pack2bf(float lo, float hi) { const hwbf16x2 v = {(__bf16)lo, (__bf16)hi}; return __builtin_bit_cast(unsigned, v); }
#endif
#ifdef HOST_EMU
__device__ __forceinline__ unsigned pack4f8(float a, float b, float c, float d) { return (unsigned)emu_f2fp8(a) | ((unsigned)emu_f2fp8(b) << 8) | ((unsigned)emu_f2fp8(c) << 16) | ((unsigned)emu_f2fp8(d) << 24); }
#else
__device__ __forceinline__ float clampf8(float x) { return fminf(fmaxf(x, -448.f), 448.f); }
__device__ __forceinline__ unsigned pack4f8(float a, float b, float c, float d) { int v = __builtin_amdgcn_cvt_pk_fp8_f32(clampf8(a), clampf8(b), 0, false); v = __builtin_amdgcn_cvt_pk_fp8_f32(clampf8(c), clampf8(d), v, true); return (unsigned)v; }
#endif
constexpr float F8_SA = 4.f, F8_SW = 32.f, F8_SH = 8.f, F8_SY = 16.f;
#ifdef HOST_EMU
__device__ __forceinline__ void unpack4f8(unsigned v, float (&o)[4]) { for (int i = 0; i < 4; ++i) o[i] = emu_fp82f((unsigned char)(v >> (8 * i))); }
#else
typedef float f32x2 __attribute__((ext_vector_type(2)));
__device__ __forceinline__ void unpack4f8(unsigned v, float (&o)[4]) { const f32x2 lo = __builtin_amdgcn_cvt_pk_f32_fp8((int)v, false), hi = __builtin_amdgcn_cvt_pk_f32_fp8((int)v, true); o[0] = lo[0]; o[1] = lo[1]; o[2] = hi[0]; o[3] = hi[1]; }
#endif
#ifdef HOST_EMU
__device__ __forceinline__ float rcpf_(float x) { return 1.f / x; }
__device__ __forceinline__ float rsqf_(float x) { return 1.f / sqrtf(x); }
#else
__device__ __forceinline__ float rcpf_(float x) { return __builtin_amdgcn_rcpf(x); }
__device__ __forceinline__ float rsqf_(float x) { return __builtin_amdgcn_rsqf(x); }
#endif
__device__ __forceinline__ float sigmoidf_(float x) { return rcpf_(1.f + __expf(-x)); }
__device__ __forceinline__ float siluf_(float x) { return x * rcpf_(1.f + __expf(-x)); }
__device__ __forceinline__ float logsigmoidf_(float x) { return fminf(x, 0.f) - log1pf(__expf(-fabsf(x))); }
__device__ __forceinline__ float logsigmoid_fast(float x) { return fminf(x, 0.f) - __logf(1.f + __expf(-fabsf(x))); }
__device__ __forceinline__ float gelu_tanhf_(float x) { float u = 0.7978845608028654f * (x + 0.044715f * x * x * x); float t = 1.f - 2.f * rcpf_(1.f + __expf(2.f * u)); return 0.5f * x * (1.f + t); }
#ifdef HOST_EMU
__device__ __forceinline__ float shx(float v, int m, int lane) { (void)lane; return __shfl_xor(v, m); }
__device__ __forceinline__ int shx(int v, int m, int lane) { (void)lane; return __shfl_xor(v, m); }
__device__ __forceinline__ float shfl_from(float v, int src, int lane) { (void)lane; return __shfl(v, src); }
#else
__device__ __forceinline__ float shx(float v, int m, int lane) { return __builtin_bit_cast(float, __builtin_amdgcn_ds_bpermute((lane ^ m) << 2, __builtin_bit_cast(int, v))); }
__device__ __forceinline__ int shx(int v, int m, int lane) { return __builtin_amdgcn_ds_bpermute((lane ^ m) << 2, v); }
__device__ __forceinline__ float shfl_from(float v, int src, int lane) { (void)lane; return __builtin_bit_cast(float, __builtin_amdgcn_ds_bpermute(src << 2, __builtin_bit_cast(int, v))); }
#endif
__device__ __forceinline__ float wave_sum(float v, int lane) { for (int m = 32; m >= 1; m >>= 1) v += shx(v, m, lane); return v; }
__device__ __forceinline__ float group16_sum(float v, int lane) { for (int m = 8; m >= 1; m >>= 1) v += shx(v, m, lane); return v; }

enum { I_X = 0, I_C, I_CTX, I_CCTX, I_MODW, I_MODB, I_NMIXG, I_NFFNG, I_EVWIN, I_EVBIN, I_EVCONVW, I_EVCONVB, I_EVMNORM,
       I_AREF, I_AIMF, I_LDTF, I_AREB, I_AIMB, I_LDTB, I_S5BRE, I_S5BIM, I_S5CRE, I_S5CIM, I_S5D, I_GLUW, I_GLUB, I_EVWOUT,
       I_ODWIN, I_ODW2F, I_ODB2F, I_ODW2B, I_ODB2B, I_ODNORM, I_ODWOUT, I_RW, I_RB, I_WGU, I_BGU, I_WDN, I_BDN, I_FNORM, N_INPUTS };

struct Params { const float* in[N_INPUTS]; float* out; char* ws; };

constexpr size_t al256(size_t x) { return (x + 255) & ~(size_t)255; }
constexpr int XCD_BAR_WORDS_C = 3456;
constexpr size_t WS_BAR = 0;
constexpr int N_BAR_SLOTS = 4;
constexpr size_t WS_CNT = WS_BAR + (size_t)N_BAR_SLOTS * XCD_BAR_WORDS_C * 4;
constexpr size_t WS_ZERO_BYTES = al256(WS_CNT + (size_t)DEPTH * NE * 4);
constexpr size_t WS_MODV = WS_ZERO_BYTES;
constexpr size_t WS_H = al256(WS_MODV + (size_t)DEPTH * (BATCH + 1) * 6 * D * 4);
constexpr size_t WS_A = al256(WS_H + (size_t)NT * D * 4);
constexpr size_t WS_CAT = al256(WS_A + (size_t)NT * D * 2);
constexpr size_t WS_Z = al256(WS_CAT + (size_t)NT * D * 2);
constexpr size_t WS_GATES = al256(WS_Z + (size_t)NT * ZLD * 2);
constexpr size_t WS_QK = al256(WS_GATES + (size_t)NT * 32 * 4);
constexpr size_t WS_MO = al256(WS_QK + (size_t)NT * D * 2);
constexpr size_t WS_YY = al256(WS_MO + (size_t)2 * NT * D * 4);
constexpr size_t WS_TOKE = al256(WS_YY + (size_t)NT * 512 * 2);
constexpr size_t WS_TOKPOS = al256(WS_TOKE + (size_t)NT * 4 * 4);
constexpr size_t WS_TOKGATE = al256(WS_TOKPOS + (size_t)NT * 4 * 4);
constexpr size_t WS_ROWTOK = al256(WS_TOKGATE + (size_t)NT * 4 * 4);
constexpr size_t WS_HDN = al256(WS_ROWTOK + (size_t)NE * NT * 4);
constexpr size_t WS_YB = al256(WS_HDN + (size_t)ROWS_MAX * D * 2);
constexpr size_t WS_WEVIN = al256(WS_YB + (size_t)ROWS_MAX * D * 2);
constexpr size_t WS_WODIN = al256(WS_WEVIN + (size_t)N_EVEN * P_EVEN_PAD * D * 2);
constexpr size_t WS_WEVOUT = al256(WS_WODIN + (size_t)N_ODD * P_ODD_PAD * D * 2);
constexpr size_t WS_WGLU = al256(WS_WEVOUT + (size_t)N_EVEN * D * D * 2);
constexpr size_t WS_WODOUT = al256(WS_WGLU + (size_t)N_EVEN * 512 * 512 * 2);
constexpr size_t WS_WGU = al256(WS_WODOUT + (size_t)N_ODD * D * D * 2);
constexpr size_t WS_WDN = al256(WS_WGU + (size_t)DEPTH * NE * 2 * D * D * 2);
constexpr size_t WS_S5AB = al256(WS_WDN + (size_t)DEPTH * NE * D * D * 2);
constexpr size_t WS_S5CZ = al256(WS_S5AB + (size_t)N_EVEN * 64 * 128 * 4);
constexpr size_t WS_S5BT = al256(WS_S5CZ + (size_t)N_EVEN * 64 * 16 * 128 * 2);
constexpr size_t WS_RWT = al256(WS_S5BT + (size_t)N_EVEN * 32 * 128 * 16 * 2);
constexpr int GI_Q = 0, GI_KD = 16384, GI_P = 32768, GI_VT = 40960, GI_DEC = 73728, GI_BYTES = 74240;
constexpr size_t WS_GIMG = al256(WS_RWT + (size_t)DEPTH * NE * D * 4);
constexpr size_t WS_TOTAL = al256(WS_GIMG + (size_t)BATCH * 2 * NCH * 4 * GI_BYTES);

__device__ __forceinline__ int mod_row(int r) { return r < NT_CTX ? BATCH : (r - NT_CTX) / SEQ; }
__device__ __forceinline__ const float* modv(const Params& P, int layer, int r, int part) { return (const float*)(P.ws + WS_MODV) + ((size_t)(layer * (BATCH + 1) + mod_row(r)) * 6 + part) * D; }

constexpr int GEMM_STAGE = 32768 + 16384, GEMM_LDS = 3 * GEMM_STAGE;
#ifdef HOST_EMU
#define WAIT_VM6() do {} while (0)
#define RAW_BARRIER() __syncthreads()
#else
#define WAIT_VM6() asm volatile("s_waitcnt vmcnt(6)" ::: "memory")
#define RAW_BARRIER() do { __builtin_amdgcn_s_barrier(); asm volatile("" ::: "memory"); } while (0)
#endif
template <class ARow, class Epi>
__device__ __forceinline__ void gemm_tile(int wv, char* smem, ARow arow, const bf16_t* Bt, int ldb, int K, Epi epi) {
    const int tid = tidx(wv), wid = tid >> 6, lane = tid & 63, wr = wid >> 1, wc = wid & 1, fr = lane & 15, fq = lane >> 4;
    const char* ap[4]; const char* bp[2];
#pragma unroll
    for (int i = 0; i < 4; ++i) { const int id = tid + i * 512, row = id >> 3, c = (id & 7) ^ (row & 7); ap[i] = (const char*)arow(row) + c * 16; }
#pragma unroll
    for (int i = 0; i < 2; ++i) { const int id = tid + i * 512, row = id >> 3, c = (id & 7) ^ (row & 7); bp[i] = (const char*)(Bt + (size_t)row * ldb) + c * 16; }
    f32x4 acc[4][4];
#pragma unroll
    for (int m = 0; m < 4; ++m)
#pragma unroll
        for (int n = 0; n < 4; ++n) acc[m][n] = f32x4{0.f, 0.f, 0.f, 0.f};
    const int nt = K / 64;
    auto stage = [&](int t, int buf) {
        char* sa = smem + buf * GEMM_STAGE; char* sb = sa + 32768;
#pragma unroll
        for (int i = 0; i < 4; ++i) GLDS16(ap[i] + (size_t)t * 128, sa + (tid + i * 512) * 16);
#pragma unroll
        for (int i = 0; i < 2; ++i) GLDS16(bp[i] + (size_t)t * 128, sb + (tid + i * 512) * 16);
    };
    WAIT_VM0();
    stage(0, 0);
    stage(1, 1);
    int cur = 0;
    for (int t = 0; t < nt; ++t) {
        if (t + 1 < nt) WAIT_VM6(); else WAIT_VM0();
        RAW_BARRIER();
        if (t + 2 < nt) stage(t + 2, cur >= 1 ? cur - 1 : 2);
        const char* sa = smem + cur * GEMM_STAGE; const char* sb = sa + 32768;
#pragma unroll
        for (int kk = 0; kk < 2; ++kk) {
            bf16x8 af[4], bfr[4];
#pragma unroll
            for (int m = 0; m < 4; ++m) { const int row = wr * 64 + m * 16 + fr; af[m] = *(const bf16x8*)(sa + row * 128 + (((kk * 4 + fq) ^ (row & 7)) << 4)); }
#pragma unroll
            for (int n = 0; n < 4; ++n) { const int row = wc * 64 + n * 16 + fr; bfr[n] = *(const bf16x8*)(sb + row * 128 + (((kk * 4 + fq) ^ (row & 7)) << 4)); }
#pragma unroll
            for (int m = 0; m < 4; ++m)
#pragma unroll
                for (int n = 0; n < 4; ++n) acc[m][n] = MFMA16(af[m], bfr[n], acc[m][n]);
        }
        cur = cur == 2 ? 0 : cur + 1;
    }
    epi(acc, wr, wc, fr, fq);
    __syncthreads();
}
constexpr int G2_HT = 128 * 64;
constexpr int GEMM2_LDS = 8 * G2_HT * 2;
#ifdef HOST_EMU
#define G2_WAIT_V(n) do {} while (0)
#define G2_WAIT_L(n) do {} while (0)
#define G2_BAR __syncthreads()
#define G2_SCHED do {} while (0)
#define G2_PRIO(x) do {} while (0)
#else
#define G2_WAIT_V(n) asm volatile("s_waitcnt vmcnt(" #n ")" ::: "memory")
#define G2_WAIT_L(n) asm volatile("s_waitcnt lgkmcnt(" #n ")" ::: "memory")
#define G2_BAR __builtin_amdgcn_s_barrier()
#define G2_SCHED __builtin_amdgcn_sched_barrier(0)
#define G2_PRIO(x) __builtin_amdgcn_s_setprio(x)
#endif
__device__ __forceinline__ int g2_lds_byte(int r, int c) { const int st = (r >> 4) * 2 + (c >> 5), rr = r & 15, cc = c & 31, ob = rr * 64 + cc * 2; return st * 1024 + (ob ^ (((ob >> 9) & 1) << 5)); }
__device__ __forceinline__ void g2_stage_rc(int b, int& R, int& C) { const int st = b / 1024, sb = b % 1024, swz = sb ^ (((sb >> 9) & 1) << 5); R = (st >> 1) * 16 + swz / 64; C = (st & 1) * 32 + (swz % 64) / 2; }
struct G2NoPre { __device__ __forceinline__ void operator()() const {} };
template <bool F8 = false, class ARow, class Epi, class Pre = G2NoPre>
__device__ __forceinline__ void gemm_tile256(int wv, char* smem, const bf16_t* Abase, ARow arow  , const bf16_t* Bt, int ldb, int K, Epi epi, Pre pre = Pre()) {
    bf16_t* shm = (bf16_t*)smem;
#define G2_SA(b, h) (shm + ((b) * 2 + (h)) * G2_HT)
#define G2_SB(b, h) (shm + (4 + (b) * 2 + (h)) * G2_HT)
    const int tid = tidx(wv), wid = tid >> 6, lane = tid & 63, wr = wid >> 2, wc = wid & 3, fr = lane & 15, fq = lane >> 4;
    unsigned pa[2][2], pb;
    {
        int R, C;
        g2_stage_rc(tid * 16, R, C);
        pa[0][0] = arow(R) + (unsigned)C; pa[0][1] = arow(R + 64) + (unsigned)C; pa[1][0] = arow(128 + R) + (unsigned)C; pa[1][1] = arow(192 + R) + (unsigned)C; pb = (unsigned)(R * ldb + C);
    }
    const size_t bhalf = (size_t)128 * ldb;
#define G2_CAT8(x, y) __builtin_shufflevector(x, y, 0, 1, 2, 3, 4, 5, 6, 7)
#define G2_STAGE_A(Pp, h, kt) do { _Pragma("unroll") for (int _i = 0; _i < 2; ++_i) GLDS16(Abase + pa[h][_i] + (kt) * 64, (char*)(Pp) + tid * 16 + _i * 8192); } while (0)
#define G2_STAGE_B(Pp, h, kt) do { _Pragma("unroll") for (int _i = 0; _i < 2; ++_i) GLDS16(Bt + (h) * bhalf + (size_t)(_i * 64) * ldb + pb + (kt) * 64, (char*)(Pp) + tid * 16 + _i * 8192); } while (0)
#define G2_LDA(dst, b, h) do { _Pragma("unroll") for (int m = 0; m < 4; ++m) { const i32x4 _lo = *(const i32x4*)((const char*)G2_SA(b, h) + g2_lds_byte(wr * 64 + m * 16 + fr, fq * 8)), _hi = *(const i32x4*)((const char*)G2_SA(b, h) + g2_lds_byte(wr * 64 + m * 16 + fr, 32 + fq * 8)); dst[m] = G2_CAT8(_lo, _hi); } } while (0)
#define G2_LDB(dst, b, h) do { _Pragma("unroll") for (int n = 0; n < 2; ++n) { const i32x4 _lo = *(const i32x4*)((const char*)G2_SB(b, h) + g2_lds_byte(wc * 32 + n * 16 + fr, fq * 8)), _hi = *(const i32x4*)((const char*)G2_SB(b, h) + g2_lds_byte(wc * 32 + n * 16 + fr, 32 + fq * 8)); dst[n] = G2_CAT8(_lo, _hi); } } while (0)
#define G2_LO(x) __builtin_bit_cast(bf16x8, __builtin_shufflevector(x, x, 0, 1, 2, 3))
#define G2_HI(x) __builtin_bit_cast(bf16x8, __builtin_shufflevector(x, x, 4, 5, 6, 7))
#define G2_MMA(ai, bj, Af, Bf) do { G2_PRIO(1); _Pragma("unroll") for (int m = 0; m < 4; ++m) _Pragma("unroll") for (int n = 0; n < 2; ++n) { \
        if (F8) acc[ai][bj][m][n] = MFMA128F8(Bf[n], Af[m], acc[ai][bj][m][n]); \
        else { acc[ai][bj][m][n] = MFMA16(G2_LO(Bf[n]), G2_LO(Af[m]), acc[ai][bj][m][n]); acc[ai][bj][m][n] = MFMA16(G2_HI(Bf[n]), G2_HI(Af[m]), acc[ai][bj][m][n]); } } G2_PRIO(0); } while (0)
    f32x4 acc[2][2][4][2];
#pragma unroll
    for (int a = 0; a < 2; ++a)
#pragma unroll
        for (int b = 0; b < 2; ++b)
#pragma unroll
            for (int m = 0; m < 4; ++m)
#pragma unroll
                for (int n = 0; n < 2; ++n) acc[a][b][m][n] = f32x4{0.f, 0.f, 0.f, 0.f};
    i32x8 At[4], B0[2], B1[2];
    const int nt = K / 64;
    G2_WAIT_V(0);
    pre(); G2_SCHED;
    G2_STAGE_B(G2_SB(0, 0), 0, 0); G2_STAGE_A(G2_SA(0, 0), 0, 0); G2_STAGE_B(G2_SB(0, 1), 1, 0); G2_STAGE_A(G2_SA(0, 1), 1, 0);
    if (wr == 1) G2_BAR;
    G2_WAIT_V(4); G2_BAR;
    G2_STAGE_B(G2_SB(1, 0), 0, 1); G2_STAGE_A(G2_SA(1, 0), 0, 1); G2_STAGE_B(G2_SB(1, 1), 1, 1);
    G2_WAIT_V(6); G2_BAR;
    for (int t = 0; t < nt - 2; t += 2) {
        G2_LDB(B0, 0, 0); G2_SCHED; G2_LDA(At, 0, 0); G2_STAGE_A(G2_SA(1, 1), 1, t + 1);
        G2_WAIT_L(8); G2_BAR; G2_WAIT_L(0); G2_MMA(0, 0, At, B0); G2_BAR; G2_SCHED;
        G2_LDB(B1, 0, 1); G2_STAGE_B(G2_SB(0, 0), 0, t + 2);
        G2_BAR; G2_WAIT_L(0); G2_MMA(0, 1, At, B1); G2_BAR;
        G2_LDA(At, 0, 1); G2_STAGE_A(G2_SA(0, 0), 0, t + 2);
        G2_BAR; G2_WAIT_L(0); G2_MMA(1, 0, At, B0); G2_BAR; G2_SCHED;
        G2_STAGE_B(G2_SB(0, 1), 1, t + 2);
        G2_WAIT_V(6); G2_BAR; G2_MMA(1, 1, At, B1); G2_BAR;
        G2_LDB(B0, 1, 0); G2_SCHED; G2_LDA(At, 1, 0); G2_STAGE_A(G2_SA(0, 1), 1, t + 2);
        G2_WAIT_L(8); G2_BAR; G2_WAIT_L(0); G2_MMA(0, 0, At, B0); G2_BAR; G2_SCHED;
        G2_LDB(B1, 1, 1); G2_STAGE_B(G2_SB(1, 0), 0, t + 3);
        G2_BAR; G2_WAIT_L(0); G2_MMA(0, 1, At, B1); G2_BAR;
        G2_LDA(At, 1, 1); G2_STAGE_A(G2_SA(1, 0), 0, t + 3);
        G2_BAR; G2_WAIT_L(0); G2_MMA(1, 0, At, B0); G2_BAR; G2_SCHED;
        G2_STAGE_B(G2_SB(1, 1), 1, t + 3);
        G2_WAIT_V(6); G2_BAR; G2_MMA(1, 1, At, B1); G2_BAR;
    }
    { G2_LDB(B0, 0, 0); G2_WAIT_V(0); G2_LDA(At, 0, 0); G2_STAGE_A(G2_SA(1, 1), 1, nt - 1);
      G2_BAR; G2_WAIT_L(0); G2_MMA(0, 0, At, B0); G2_BAR;
      G2_LDB(B1, 0, 1); G2_BAR; G2_WAIT_L(0); G2_MMA(0, 1, At, B1); G2_BAR;
      G2_LDA(At, 0, 1); G2_WAIT_V(4); G2_BAR; G2_WAIT_L(0); G2_MMA(1, 0, At, B0); G2_MMA(1, 1, At, B1); G2_BAR; }
    { G2_LDB(B0, 1, 0); G2_LDA(At, 1, 0); G2_WAIT_V(2); G2_BAR; G2_WAIT_L(0); G2_MMA(0, 0, At, B0); G2_BAR;
      G2_LDB(B1, 1, 1); G2_WAIT_V(0); G2_BAR; G2_WAIT_L(0); G2_MMA(0, 1, At, B1); G2_BAR;
      G2_LDA(At, 1, 1); G2_BAR; G2_WAIT_L(0); G2_MMA(1, 0, At, B0); G2_MMA(1, 1, At, B1); G2_BAR; }
    if (wr == 0) G2_BAR;
    { const int t2 = tidx(wv), w2 = t2 >> 6, l2 = t2 & 63; epi(acc, w2 >> 2, w2 & 3, l2 & 15, l2 >> 4); }
    __syncthreads();
}
template <class F> __device__ __forceinline__ void epi256_vec4(f32x4 (&acc)[2][2][4][2], int wr, int wc, int fr, int fq, F f) {
#pragma unroll
    for (int ai = 0; ai < 2; ++ai)
#pragma unroll
        for (int bj = 0; bj < 2; ++bj)
#pragma unroll
            for (int m = 0; m < 4; ++m)
#pragma unroll
                for (int n = 0; n < 2; ++n) f(ai * 128 + wr * 64 + m * 16 + fr, bj * 128 + wc * 32 + n * 16 + fq * 4, acc[ai][bj][m][n]);
}

template <class F> __device__ __forceinline__ void epi_each(f32x4 (&acc)[4][4], int wr, int wc, int fr, int fq, F f) {
#pragma unroll
    for (int m = 0; m < 4; ++m)
#pragma unroll
        for (int n = 0; n < 4; ++n)
#pragma unroll
            for (int j = 0; j < 4; ++j) f(wr * 64 + m * 16 + fq * 4 + j, wc * 64 + n * 16 + fr, acc[m][n][j]);
}

struct TJob { const float* src; bf16_t* dst; int K, N, Npad, nmat, perm, f8; };
__device__ __forceinline__ void transpose_tile(int wv, char* smem, const TJob& J, int mat, int kt, int ntile) {
    float* s = (float*)smem;
    const float* src = J.src + (size_t)mat * J.K * J.N;
    bf16_t* dst = J.dst + (size_t)mat * J.Npad * J.K;
    const int tid = tidx(wv);
    float4 v[8];
#pragma unroll
    for (int i = 0; i < 8; ++i) { const int e = tid + i * 512, kr = e >> 6, n = ntile * 256 + (e & 63) * 4; v[i] = (n < J.N) ? *(const float4*)(src + (size_t)(kt * 64 + kr) * J.N + n) : make_float4(0.f, 0.f, 0.f, 0.f); }
#pragma unroll
    for (int i = 0; i < 8; ++i) { const int e = tid + i * 512, kr = e >> 6, nc = (e & 63) * 4; float* d = s + kr * 257 + nc; d[0] = v[i].x; d[1] = v[i].y; d[2] = v[i].z; d[3] = v[i].w; }
    __syncthreads();
#pragma unroll
    for (int i = 0; i < 4; ++i) {
        const int e = tid + i * 512, nr = e >> 3, k0 = (e & 7) * 8;
        int srcc = nr;
        if (J.perm) { const int blk = nr & ~31, w = nr & 31; srcc = blk | ((w & 15) << 1) | (w >> 4); }
        const float* c = s + k0 * 257 + srcc;
        if (J.f8) {
            unsigned char* d8 = (unsigned char*)J.dst + ((size_t)mat * J.Npad + ntile * 256 + nr) * J.K + kt * 64 + k0;
            *(u32x2*)d8 = u32x2{pack4f8(c[0] * F8_SW, c[257] * F8_SW, c[2 * 257] * F8_SW, c[3 * 257] * F8_SW), pack4f8(c[4 * 257] * F8_SW, c[5 * 257] * F8_SW, c[6 * 257] * F8_SW, c[7 * 257] * F8_SW)};
        } else {
        const u32x4 o = u32x4{pack2bf(c[0], c[257]), pack2bf(c[2 * 257], c[3 * 257]), pack2bf(c[4 * 257], c[5 * 257]), pack2bf(c[6 * 257], c[7 * 257])};
        if (ntile * 256 + nr < J.Npad) *(u32x4*)(dst + (size_t)(ntile * 256 + nr) * J.K + kt * 64 + k0) = o;
        }
    }
    __syncthreads();
}
__device__ __forceinline__ void modvec_item(int wv, char* smem, const Params& P, int item) {
    float* sc = (float*)smem;
    float* red = sc + (BATCH + 1) * D;
    const int tid = tidx(wv), layer = item / (6 * D / 64), col0 = (item % (6 * D / 64)) * 64;
    for (int e = tid; e < (BATCH + 1) * D; e += NTHREADS) { const int b = e / D, k = e % D; const float v = (b < BATCH) ? P.in[I_C][b * D + k] : P.in[I_CCTX][k]; sc[e] = siluf_(v); }
    __syncthreads();
    const int cl = tid & 63, ks = tid >> 6;
    float acc[BATCH + 1];
#pragma unroll
    for (int b = 0; b <= BATCH; ++b) acc[b] = 0.f;
    const float* W = P.in[I_MODW] + (size_t)layer * D * 6 * D + col0 + cl;
    for (int k = ks * 128; k < ks * 128 + 128; ++k) {
        const float w = W[(size_t)k * 6 * D];
#pragma unroll
        for (int b = 0; b <= BATCH; ++b) acc[b] += sc[b * D + k] * w;
    }
#pragma unroll
    for (int b = 0; b <= BATCH; ++b) red[(ks * (BATCH + 1) + b) * 64 + cl] = acc[b];
    __syncthreads();
    for (int e = tid; e < (BATCH + 1) * 64; e += NTHREADS) {
        const int b = e >> 6, c = e & 63; float s = 0.f;
#pragma unroll
        for (int q = 0; q < 8; ++q) s += red[(q * (BATCH + 1) + b) * 64 + c];
        ((float*)(P.ws + WS_MODV))[((size_t)layer * (BATCH + 1) + b) * 6 * D + col0 + c] = s + P.in[I_MODB][layer * 6 * D + col0 + c];
    }
    __syncthreads();
}
__device__ __forceinline__ void s5_tables_item(int wv, const Params& P, int item) {
    const int tid = tidx(wv), wid = tid >> 6, lane = tid & 63;
    const int idx = item * 8 + wid;
    if (idx < N_EVEN * 64) {
        const int g = idx & 31, dir = (idx >> 5) & 1, j = idx >> 6;
        const float* are = P.in[dir ? I_AREB : I_AREF] + ((size_t)j * 32 + g) * 64; const float* aim = P.in[dir ? I_AIMB : I_AIMF] + ((size_t)j * 32 + g) * 64;
        const float dt = expf(P.in[dir ? I_LDTB : I_LDTF][j * 32 + g]);
        const float lre = fminf(are[lane], -1e-4f), lim = aim[lane];
        const float dec = expf(lre * dt), abr = dec * cosf(lim * dt), abi = dec * sinf(lim * dt);
        const float den = lre * lre + lim * lim;
        const float zr = ((abr - 1.f) * lre + abi * lim) / den, zi = (abi * lre - (abr - 1.f) * lim) / den;
        float* AB = (float*)(P.ws + WS_S5AB) + (size_t)idx * 128; AB[lane] = abr; AB[64 + lane] = abi;
        bf16_t* CZ = (bf16_t*)(P.ws + WS_S5CZ) + (size_t)idx * 16 * 128;
        const float* cre = P.in[I_S5CRE] + ((size_t)j * 32 + g) * 16 * 64; const float* cim = P.in[I_S5CIM] + ((size_t)j * 32 + g) * 16 * 64;
        for (int c = 0; c < 16; ++c) { const float cr = cre[c * 64 + lane], ci = cim[c * 64 + lane]; CZ[c * 128 + lane] = f2bf(cr * zr - ci * zi); CZ[c * 128 + 64 + lane] = f2bf(-(cr * zi + ci * zr)); }
        if (dir == 0) {
            bf16_t* BT = (bf16_t*)(P.ws + WS_S5BT) + ((size_t)j * 32 + g) * 128 * 16;
            const float* bre = P.in[I_S5BRE] + ((size_t)j * 32 + g) * 64 * 16; const float* bim = P.in[I_S5BIM] + ((size_t)j * 32 + g) * 64 * 16;
            for (int c = 0; c < 16; ++c) { BT[lane * 16 + c] = f2bf(bre[lane * 16 + c]); BT[(64 + lane) * 16 + c] = f2bf(bim[lane * 16 + c]); }
        }
    }
}
static __device__ __forceinline__ void phase_prologue(char* smem, const Params& P, int bid, int nb, int wv) {
    const int n_mod = DEPTH * (6 * D / 64);
    for (int it = bid; it < n_mod; it += nb) modvec_item(wv, smem, P, it);
    for (int it = bid; it < (N_EVEN * 64 + 7) / 8; it += nb) s5_tables_item(wv, P, it);
    for (int e = bid * NTHREADS + tidx(wv); e < DEPTH * D * NE; e += nb * NTHREADS) {
        const int l = e / (D * NE), k = (e / NE) % D, x = e % NE; const float w = P.in[I_RW][e]; const bf16_t hi = f2bf(w), lo = f2bf(w - bf2f(hi));
        bf16_t* dst = (bf16_t*)(P.ws + WS_RWT); dst[((size_t)(l * 2 + 0) * NE + x) * D + k] = hi; dst[((size_t)(l * 2 + 1) * NE + x) * D + k] = lo; }
    auto run = [&](const float* src, bf16_t* dst, int K, int N, int Npad, int nmat, int perm, int f8) {
        TJob J; J.src = src; J.dst = dst; J.K = K; J.N = N; J.Npad = Npad; J.nmat = nmat; J.perm = perm; J.f8 = f8;
        const int tk = K / 64, tn = (Npad + 255) / 256, per = tk * tn, total = per * nmat;
        for (int it = bid; it < total; it += nb) { const int mat = it / per, r = it % per; transpose_tile(wv, smem, J, mat, r % tk, r / tk); }
    };
    run(P.in[I_EVWIN], (bf16_t*)(P.ws + WS_WEVIN), D, P_EVEN, P_EVEN_PAD, N_EVEN, 0, 0);
    run(P.in[I_ODWIN], (bf16_t*)(P.ws + WS_WODIN), D, P_ODD, P_ODD_PAD, N_ODD, 0, 0);
    run(P.in[I_EVWOUT], (bf16_t*)(P.ws + WS_WEVOUT), D, D, D, N_EVEN, 0, 0);
    run(P.in[I_GLUW], (bf16_t*)(P.ws + WS_WGLU), 512, 512, 512, N_EVEN, 0, 0);
    run(P.in[I_ODWOUT], (bf16_t*)(P.ws + WS_WODOUT), D, D, D, N_ODD, 0, 0);
    run(P.in[I_WGU], (bf16_t*)(P.ws + WS_WGU), D, 2 * D, 2 * D, DEPTH * NE, 1, 1);
    run(P.in[I_WDN], (bf16_t*)(P.ws + WS_WDN), D, D, D, DEPTH * NE, 0, 1);
}

constexpr int MOE_RBE_MAX = 640;
static_assert(ROWS_MAX / MOE_BM <= MOE_RBE_MAX, "row-block table");
__device__ __forceinline__ void moe_offsets(int wv, const unsigned* counts, int* s_off, int* s_rbe = nullptr) {
    if (tidx(wv) == 0) { int o = 0; for (int e = 0; e < NE; ++e) { s_off[e] = o; o += (int)((counts[e] + MOE_BM - 1) / MOE_BM) * MOE_BM; } s_off[NE] = o; }
    __syncthreads();
    if (s_rbe) {
        const int e = tidx(wv);
        if (e < NE) { for (int rb = s_off[e] / MOE_BM; rb < s_off[e + 1] / MOE_BM; ++rb) s_rbe[rb] = e; s_rbe[MOE_RBE_MAX + e] = (int)counts[e]; }
        __syncthreads();
    }
}

static __device__ __forceinline__ void phase_norm1(char* smem, const Params& P, int layer, int bid, int nb, int wv) {
    int* s_off = (int*)smem;
    if (layer > 0) moe_offsets(wv, (const unsigned*)(P.ws + WS_CNT) + (layer - 1) * NE, s_off);
    const int wid = tidx(wv) >> 6, lane = tidx(wv) & 63;
    bf16_t* H = (bf16_t*)(P.ws + WS_H); bf16_t* A = (bf16_t*)(P.ws + WS_A);
    const bf16_t* YB = (const bf16_t*)(P.ws + WS_YB);
    const float* gmix = P.in[I_NMIXG] + layer * D;
    for (int r = bid * 8 + wid; r < NT; r += nb * 8) {
        float v[16];
        if (layer == 0) {
            const float* src = (r < NT_CTX) ? P.in[I_CTX] + (size_t)r * D : P.in[I_X] + (size_t)(r - NT_CTX) * D;
#pragma unroll
            for (int i = 0; i < 4; ++i) { const float4 t = *(const float4*)(src + 256 * i + 4 * lane); v[4 * i] = t.x; v[4 * i + 1] = t.y; v[4 * i + 2] = t.z; v[4 * i + 3] = t.w; }
        } else {
#pragma unroll
            for (int i = 0; i < 4; ++i) { const u32x2 t = *(const u32x2*)(H + (size_t)r * D + 256 * i + 4 * lane); v[4 * i] = bf2f((bf16_t)(t[0] & 0xffff)); v[4 * i + 1] = bf2f((bf16_t)(t[0] >> 16)); v[4 * i + 2] = bf2f((bf16_t)(t[1] & 0xffff)); v[4 * i + 3] = bf2f((bf16_t)(t[1] >> 16)); }
            const int* te = (const int*)(P.ws + WS_TOKE) + r * 4; const int* tp = (const int*)(P.ws + WS_TOKPOS) + r * 4; const float* tg = (const float*)(P.ws + WS_TOKGATE) + r * 4;
            const float* g2 = modv(P, layer - 1, r, 5);
            float mo[16];
#pragma unroll
            for (int i = 0; i < 16; ++i) mo[i] = 0.f;
#pragma unroll
            for (int k = 0; k < 4; ++k) {
                const size_t row = (size_t)(s_off[te[k]] + tp[k]); const float g = tg[k] * (1.f / F8_SY);
#pragma unroll
                for (int i = 0; i < 4; ++i) { float y[4]; unpack4f8(*(const unsigned*)((const unsigned char*)YB + row * D + 256 * i + 4 * lane), y);
                    mo[4 * i] += g * y[0]; mo[4 * i + 1] += g * y[1]; mo[4 * i + 2] += g * y[2]; mo[4 * i + 3] += g * y[3]; }
            }
#pragma unroll
            for (int i = 0; i < 4; ++i) { const float4 t = *(const float4*)(g2 + 256 * i + 4 * lane); v[4 * i] += t.x * mo[4 * i]; v[4 * i + 1] += t.y * mo[4 * i + 1]; v[4 * i + 2] += t.z * mo[4 * i + 2]; v[4 * i + 3] += t.w * mo[4 * i + 3]; }
        }
#pragma unroll
        for (int i = 0; i < 4; ++i) *(u32x2*)(H + (size_t)r * D + 256 * i + 4 * lane) = u32x2{pack2bf(v[4 * i], v[4 * i + 1]), pack2bf(v[4 * i + 2], v[4 * i + 3])};
        float ss = 0.f;
#pragma unroll
        for (int i = 0; i < 16; ++i) ss += v[i] * v[i];
        ss = wave_sum(ss, lane);
        const float rs = rsqf_(ss * (1.f / D) + 1e-6f);
        const float* sh = modv(P, layer, r, 0); const float* sc = modv(P, layer, r, 1);
#pragma unroll
        for (int i = 0; i < 4; ++i) {
            const int c = 256 * i + 4 * lane; const float4 g = *(const float4*)(gmix + c), s1 = *(const float4*)(sh + c), s2 = *(const float4*)(sc + c);
            const float a0 = v[4 * i] * rs * g.x * (1.f + s2.x) + s1.x, a1 = v[4 * i + 1] * rs * g.y * (1.f + s2.y) + s1.y, a2 = v[4 * i + 2] * rs * g.z * (1.f + s2.z) + s1.z, a3 = v[4 * i + 3] * rs * g.w * (1.f + s2.w) + s1.w;
            *(u32x2*)(A + (size_t)r * D + c) = u32x2{pack2bf(a0, a1), pack2bf(a2, a3)};
        }
    }
}

template <class Epi>
__device__ __forceinline__ void phase_gemm_dense(char* smem, const bf16_t* A, int lda, const bf16_t* Bt, int K, int M, int Npad, int bid, int nb, int wv, Epi epi) {
    const int tn = Npad / 256, tm = M / 256;
    const int xg = bid & 7, slot = bid >> 3, spx = nb >> 3;
    for (int t = slot;; t += spx) {
        const int pm = xg + 8 * (t / tn), pn = t % tn;
        if (pm >= tm) break;
        gemm_tile256(wv, smem, A, [&](int r) { return (unsigned)(pm * 256 + r) * (unsigned)lda; }, Bt + (size_t)pn * 256 * K, K, K,
                  [&](f32x4 (&acc)[2][2][4][2], int wr, int wc, int fr, int fq) { epi(acc, wr, wc, fr, fq, pm * 256, pn * 256); });
    }
}

__device__ __forceinline__ int vstep_row(int b, int dir, int v, bool colmajor) {
    if (v < CTXL) { const int t = dir ? CTXL - 1 - v : v; return b * CTXL + t; }
    int j = v - CTXL; if (dir) j = SEQ - 1 - j;
    const int t = colmajor ? (j % GROWS) * GRID_W + (j / GROWS) : j;
    return NT_CTX + b * SEQ + t;
}

static __device__ __forceinline__ void phase_conv(const Params& P, int j, int bid, int nb, int wv) {
    const bf16_t* Z = (const bf16_t*)(P.ws + WS_Z); bf16_t* QK = (bf16_t*)(P.ws + WS_QK);
    const float* cw = P.in[I_EVCONVW] + (size_t)j * 3 * D; const float* cb = P.in[I_EVCONVB] + (size_t)j * D;
    for (int e = bid * NTHREADS + tidx(wv); e < NT * 128; e += nb * NTHREADS) {
        const int r = e >> 7, c0 = (e & 127) * 8;
        int t, L; if (r < NT_CTX) { t = r % CTXL; L = CTXL; } else { t = (r - NT_CTX) % SEQ; L = SEQ; }
        const u32x4 zero = u32x4{0u, 0u, 0u, 0u};
        const u32x4 xc = *(const u32x4*)(Z + (size_t)r * ZLD + c0);
        const u32x4 xp = (t > 0) ? *(const u32x4*)(Z + (size_t)(r - 1) * ZLD + c0) : zero;
        const u32x4 xn = (t < L - 1) ? *(const u32x4*)(Z + (size_t)(r + 1) * ZLD + c0) : zero;
        const float sc = (c0 < 512) ? 0.08838834764831845f : 1.f;
        unsigned o[4];
#pragma unroll
        for (int q = 0; q < 4; ++q) {
            float y[2];
#pragma unroll
            for (int hh = 0; hh < 2; ++hh) {
                const int c = c0 + 2 * q + hh;
                const float a = bf2f((bf16_t)(hh ? (xp[q] >> 16) : (xp[q] & 0xffff))), b = bf2f((bf16_t)(hh ? (xc[q] >> 16) : (xc[q] & 0xffff))), d = bf2f((bf16_t)(hh ? (xn[q] >> 16) : (xn[q] & 0xffff)));
                const float v = cb[c] + cw[c] * a + cw[D + c] * b + cw[2 * D + c] * d;
                y[hh] = siluf_(v) * sc;
            }
            o[q] = pack2bf(y[0], y[1]);
        }
        *(u32x4*)(QK + (size_t)r * D + c0) = u32x4{o[0], o[1], o[2], o[3]};
    }
}

constexpr int ML_LDQ = 136, ML_LDS = 72;
constexpr int ML_OFF_Q = 0, ML_OFF_K = ML_OFF_Q + 64 * ML_LDQ * 2, ML_OFF_VT = ML_OFF_K + 64 * ML_LDQ * 2, ML_OFF_P = ML_OFF_VT + 144 * ML_LDS * 2,
              ML_OFF_KW = ML_OFF_P + 64 * ML_LDS * 2, ML_OFF_CT = ML_OFF_KW + 128 * ML_LDS * 2, ML_OFF_F = ML_OFF_CT + 144 * ML_LDQ * 2, ML_LDS_BYTES = ML_OFF_F + 5 * 64 * 4;
static __device__ __forceinline__ void phase_mlstm(char* smem, const Params& P, int bid, int nb, int wv) {
    const int tid = tidx(wv), wid = tid >> 6, lane = tid & 63, fr = lane & 15, fq = lane >> 4;
    bf16_t* sQ = (bf16_t*)(smem + ML_OFF_Q); bf16_t* sK = (bf16_t*)(smem + ML_OFF_K); bf16_t* sVt = (bf16_t*)(smem + ML_OFF_VT); bf16_t* sP = (bf16_t*)(smem + ML_OFF_P);
    bf16_t* sKw = (bf16_t*)(smem + ML_OFF_KW); bf16_t* sCt = (bf16_t*)(smem + ML_OFF_CT);
    float* sBc = (float*)(smem + ML_OFF_F); float* sIg = sBc + 64; float* sWg = sBc + 128; float* sDen = sBc + 192; float* sEb = sBc + 256;
    const bf16_t* QK = (const bf16_t*)(P.ws + WS_QK); const bf16_t* Z = (const bf16_t*)(P.ws + WS_Z); const float* G = (const float*)(P.ws + WS_GATES);
    bf16_t* MO = (bf16_t*)(P.ws + WS_MO);
    for (int it = bid; it < BATCH * 8; it += nb) {
        const int dir = it & 1, head = (it >> 1) & 3, b = it >> 3;
        for (int e = tid; e < 144 * ML_LDQ; e += NTHREADS) sCt[e] = 0;
        for (int e = tid; e < 16 * ML_LDS; e += NTHREADS) sVt[128 * ML_LDS + e] = (e < 64) ? (bf16_t)0x3F80 : (bf16_t)0;
        f32x4 Cacc[9];
#pragma unroll
        for (int n = 0; n < 9; ++n) Cacc[n] = f32x4{0.f, 0.f, 0.f, 0.f};
        __syncthreads();
        u32x4 pq[2], pk[2], pv[2]; float pig = 0.f, pfg = 0.f;
        auto issue = [&](int ci) {
#pragma unroll
            for (int i = 0; i < 2; ++i) {
                const int id = tid + i * 512, s = id >> 4, ch = id & 15; const int row = vstep_row(b, dir, ci * 64 + s, false);
                pq[i] = *(const u32x4*)(QK + (size_t)row * D + head * 128 + ch * 8);
                pk[i] = *(const u32x4*)(QK + (size_t)row * D + 512 + head * 128 + ch * 8);
            }
#pragma unroll
            for (int i = 0; i < 2; ++i) { const int id = tid + i * 512, s = id >> 4, ch = id & 15; const int row = vstep_row(b, dir, ci * 64 + s, false); pv[i] = *(const u32x4*)(Z + (size_t)row * ZLD + 1024 + head * 128 + ch * 8); }
            if (wid == 0) { const int row = vstep_row(b, dir, ci * 64 + lane, false); pig = G[(size_t)row * 32 + (dir * 2) * 4 + head]; pfg = G[(size_t)row * 32 + (dir * 2 + 1) * 4 + head]; }
        };
        issue(0);
        for (int ci = 0; ci < NCH; ++ci) {
            {
                u32x4 cq[2], ck[2], cv[2]; const float cig = pig, cfg = pfg;
#pragma unroll
                for (int i = 0; i < 2; ++i) { cq[i] = pq[i]; ck[i] = pk[i]; cv[i] = pv[i]; }
                if (ci + 1 < NCH) issue(ci + 1);
#pragma unroll
                for (int i = 0; i < 2; ++i) {
                    const int id = tid + i * 512, s = id >> 4, ch = id & 15;
                    *(u32x4*)(sQ + s * ML_LDQ + ch * 8) = cq[i];
                    *(u32x4*)(sK + s * ML_LDQ + ch * 8) = ck[i];
                }
#pragma unroll
                for (int i = 0; i < 2; ++i) {
                    const int id = tid + i * 512, s = id >> 4, ch = id & 15;
#pragma unroll
                    for (int q = 0; q < 4; ++q) { sVt[(ch * 8 + 2 * q) * ML_LDS + s] = (bf16_t)(cv[i][q] & 0xffff); sVt[(ch * 8 + 2 * q + 1) * ML_LDS + s] = (bf16_t)(cv[i][q] >> 16); }
                }
                if (wid == 0) {
                    const float ig = cig;
                    float c = logsigmoid_fast(cfg);
                    for (int d = 1; d < 64; d <<= 1) { const float n = shfl_from(c, (lane >= d) ? lane - d : lane, lane); if (lane >= d) c += n; }
                    const float bl = shfl_from(c, 63, lane);
                    sBc[lane] = c; sIg[lane] = ig; sWg[lane] = __expf(bl - c + ig); sEb[lane] = __expf(c);
                }
            }
            __syncthreads();
            {
                const int tt = wid >> 1;
                bf16x8 qa[4];
#pragma unroll
                for (int kk = 0; kk < 4; ++kk) qa[kk] = *(const bf16x8*)(sQ + (tt * 16 + fr) * ML_LDQ + kk * 32 + fq * 8);
#pragma unroll
                for (int u = 0; u < 2; ++u) {
                    const int st = (wid & 1) * 2 + u;
                    f32x4 acc = f32x4{0.f, 0.f, 0.f, 0.f};
#pragma unroll
                    for (int kk = 0; kk < 4; ++kk) {
                        const bf16x8 bb = *(const bf16x8*)(sK + (st * 16 + fr) * ML_LDQ + kk * 32 + fq * 8);
                        acc = MFMA16(qa[kk], bb, acc);
                    }
                    const int s = st * 16 + fr; const float bs = sBc[s], is = sIg[s];
#pragma unroll
                    for (int j = 0; j < 4; ++j) { const int t = tt * 16 + fq * 4 + j; const float w = (s <= t) ? __expf(sBc[t] - bs + is) : 0.f; sP[t * ML_LDS + s] = f2bf(acc[j] * w); }
                }
#pragma unroll
                for (int i = 0; i < 16; ++i) { const int e = tid + i * 512, s = e & 63, d = e >> 6; sKw[d * ML_LDS + s] = f2bf(bf2f(sK[s * ML_LDQ + d]) * sWg[s]); }
            }
            __syncthreads();
            const int tt = wid & 3, e0 = (wid < 4) ? 0 : 5, ne = (wid < 4) ? 5 : 4;
            f32x4 val[5];
            bf16x8 pa[2], qa[4];
#pragma unroll
            for (int kk = 0; kk < 2; ++kk) pa[kk] = *(const bf16x8*)(sP + (tt * 16 + fr) * ML_LDS + kk * 32 + fq * 8);
#pragma unroll
            for (int kk = 0; kk < 4; ++kk) qa[kk] = *(const bf16x8*)(sQ + (tt * 16 + fr) * ML_LDQ + kk * 32 + fq * 8);
#pragma unroll
            for (int u = 0; u < 5; ++u) {
                val[u] = f32x4{0.f, 0.f, 0.f, 0.f};
                if (u < ne) {
                    const int et = e0 + u;
                    f32x4 ai = f32x4{0.f, 0.f, 0.f, 0.f}, ao = f32x4{0.f, 0.f, 0.f, 0.f};
#pragma unroll
                    for (int kk = 0; kk < 2; ++kk) {
                        const bf16x8 bb = *(const bf16x8*)(sVt + (et * 16 + fr) * ML_LDS + kk * 32 + fq * 8);
                        ai = MFMA16(bb, pa[kk], ai);
                    }
#pragma unroll
                    for (int kk = 0; kk < 4; ++kk) {
                        const bf16x8 bb = *(const bf16x8*)(sCt + (et * 16 + fr) * ML_LDQ + kk * 32 + fq * 8);
                        ao = MFMA16(bb, qa[kk], ao);
                    }
                    const float eb = sEb[tt * 16 + fr];
#pragma unroll
                    for (int j = 0; j < 4; ++j) val[u][j] = ai[j] + eb * ao[j];
                    if (et == 8 && fq == 0) sDen[tt * 16 + fr] = val[u][0];
                }
            }
            __syncthreads();
            {
                const int t = tt * 16 + fr; const int row = vstep_row(b, dir, ci * 64 + t, false);
                const float dn = rcpf_(fmaxf(fabsf(sDen[t]), 1.f));
#pragma unroll
                for (int u = 0; u < 5; ++u) {
                    const int et = e0 + u;
                    if (u < ne && et < 8) *(u32x2*)(MO + ((size_t)dir * NT + row) * D + head * 128 + et * 16 + fq * 4) = u32x2{pack2bf(val[u][0] * dn, val[u][1] * dn), pack2bf(val[u][2] * dn, val[u][3] * dn)};
                }
            }
            {
                const float dec = sEb[63];
                bf16x8 ka[2];
#pragma unroll
                for (int kk = 0; kk < 2; ++kk) ka[kk] = *(const bf16x8*)(sKw + (wid * 16 + fr) * ML_LDS + kk * 32 + fq * 8);
#pragma unroll
                for (int n = 0; n < 9; ++n) {
                    f32x4 c = Cacc[n] * dec;
#pragma unroll
                    for (int kk = 0; kk < 2; ++kk) {
                        const bf16x8 bb = *(const bf16x8*)(sVt + (n * 16 + fr) * ML_LDS + kk * 32 + fq * 8);
                        c = MFMA16(ka[kk], bb, c);
                    }
                    Cacc[n] = c;
                    *(u32x2*)(sCt + (n * 16 + fr) * ML_LDQ + wid * 16 + fq * 4) = u32x2{pack2bf(c[0], c[1]), pack2bf(c[2], c[3])};
                }
            }
            __syncthreads();
        }
    }
}

#ifdef HOST_EMU
#define WAVE_SYNC() do { int _z = 0; (void)emu::wave_exchange(&_z, 4); } while (0)
#else
#define WAVE_SYNC() __builtin_amdgcn_wave_barrier()
#endif

constexpr int S5_LDW = 132;
constexpr int S5_WAVE_BYTES = 32 * S5_LDW * 4 + 128 * 4, S5_LDS_BYTES = 8 * S5_WAVE_BYTES;
static __device__ __forceinline__ void phase_s5(char* smem, const Params& P, int j, int bid, int nb, int wv) {
    const int tid = tidx(wv), wid = tid >> 6, lane = tid & 63, fr = lane & 15, fq = lane >> 4;
    float* BU = (float*)(smem + wid * S5_WAVE_BYTES);
    const bf16_t* Z = (const bf16_t*)(P.ws + WS_Z); bf16_t* MO = (bf16_t*)(P.ws + WS_MO);
    for (int it = bid * 8 + wid; it < BATCH * 2 * 32; it += nb * 8) {
        const int g = it & 31, dir = (it >> 5) & 1, b = it >> 6;
        const int idx = (j * 2 + dir) * 32 + g;
        const float* AB = (const float*)(P.ws + WS_S5AB) + (size_t)idx * 128;
        const float abr = AB[lane], abi = AB[64 + lane];
        bf16x8 bop[4];
        {
            const bf16_t* BT = (const bf16_t*)(P.ws + WS_S5BT) + ((size_t)j * 32 + g) * 128 * 16;
#pragma unroll
            for (int nt = 0; nt < 4; ++nt) bop[nt] = *(const bf16x8*)(BT + (nt * 32 + (lane & 31)) * 16 + 8 * (lane >> 5));
        }
        bf16x8 cop[4];
        {
            const bf16_t* CZ = (const bf16_t*)(P.ws + WS_S5CZ) + (size_t)idx * 16 * 128;
#pragma unroll
            for (int kk = 0; kk < 4; ++kk) cop[kk] = *(const bf16x8*)(CZ + fr * 128 + kk * 32 + 8 * fq);
        }
        float sre = 0.f, sim = 0.f;
        bf16x8 ua_nx = *(const bf16x8*)(Z + (size_t)vstep_row(b, dir, (lane & 31), false) * ZLD + 2064 + g * 16 + 8 * (lane >> 5));
        for (int c32 = 0; c32 < (CTXL + SEQ) / 32; ++c32) {
            const bf16x8 ua = ua_nx;
            if (c32 + 1 < (CTXL + SEQ) / 32) ua_nx = *(const bf16x8*)(Z + (size_t)vstep_row(b, dir, (c32 + 1) * 32 + (lane & 31), false) * ZLD + 2064 + g * 16 + 8 * (lane >> 5));
#pragma unroll
            for (int nt = 0; nt < 4; ++nt) {
                f32x16 d;
#pragma unroll
                for (int q = 0; q < 16; ++q) d[q] = 0.f;
                d = MFMA32(ua, bop[nt], d);
#pragma unroll
                for (int q = 0; q < 16; ++q) BU[((q & 3) + 8 * (q >> 2) + 4 * (lane >> 5)) * S5_LDW + nt * 32 + (lane & 31)] = d[q];
            }
            WAVE_SYNC();
            {
                float br[32], bi[32];
#pragma unroll
                for (int s = 0; s < 32; ++s) { br[s] = BU[s * S5_LDW + lane]; bi[s] = BU[s * S5_LDW + 64 + lane]; }
#ifndef HOST_EMU
                asm volatile("s_waitcnt lgkmcnt(0)" ::: "memory");
#endif
#pragma unroll
                for (int s = 0; s < 32; ++s) {
                    const float nr = abr * sre - abi * sim + br[s], ni = abr * sim + abi * sre + bi[s];
                    sre = nr; sim = ni; br[s] = nr; bi[s] = ni;
                }
#pragma unroll
                for (int s = 0; s < 32; ++s) { BU[s * S5_LDW + lane] = br[s]; BU[s * S5_LDW + 64 + lane] = bi[s]; }
#ifndef HOST_EMU
                asm volatile("s_waitcnt lgkmcnt(0)" ::: "memory");
#endif
            }
            WAVE_SYNC();
#pragma unroll
            for (int mt = 0; mt < 2; ++mt) {
                f32x4 acc = f32x4{0.f, 0.f, 0.f, 0.f};
#pragma unroll
                for (int kk = 0; kk < 4; ++kk) {
                    const float* sp = BU + (mt * 16 + fr) * S5_LDW + kk * 32 + fq * 8;
                    const float4 x0 = *(const float4*)sp, x1 = *(const float4*)(sp + 4);
                    bf16x8 a; a[0] = (short)f2bf(x0.x); a[1] = (short)f2bf(x0.y); a[2] = (short)f2bf(x0.z); a[3] = (short)f2bf(x0.w);
                    a[4] = (short)f2bf(x1.x); a[5] = (short)f2bf(x1.y); a[6] = (short)f2bf(x1.z); a[7] = (short)f2bf(x1.w);
                    acc = MFMA16(a, cop[kk], acc);
                }
#pragma unroll
                for (int q = 0; q < 4; ++q) { const int row = vstep_row(b, dir, c32 * 32 + mt * 16 + fq * 4 + q, false); MO[((size_t)dir * NT + row) * D + 512 + g * 16 + fr] = f2bf(acc[q]); }
            }
            WAVE_SYNC();
        }
    }
}

static __device__ __forceinline__ void phase_post_even(const Params& P, int j, int bid, int nb, int wv) {
    const int wid = tidx(wv) >> 6, lane = tidx(wv) & 63;
    const bf16_t* MO = (const bf16_t*)(P.ws + WS_MO); const bf16_t* Z = (const bf16_t*)(P.ws + WS_Z);
    bf16_t* CAT = (bf16_t*)(P.ws + WS_CAT); bf16_t* YY = (bf16_t*)(P.ws + WS_YY);
    const float* mg = P.in[I_EVMNORM] + (size_t)j * 512; const float* dsk = P.in[I_S5D] + (size_t)j * 512;
    for (int r = bid * 8 + wid; r < NT; r += nb * 8) {
        const int c0 = lane * 8;
        float m[8], s[8];
        {
            const u32x4 a0 = *(const u32x4*)(MO + (size_t)r * D + c0), b0 = *(const u32x4*)(MO + ((size_t)NT + r) * D + c0);
            const u32x4 a1 = *(const u32x4*)(MO + (size_t)r * D + 512 + c0), b1 = *(const u32x4*)(MO + ((size_t)NT + r) * D + 512 + c0);
#pragma unroll
            for (int q = 0; q < 4; ++q) {
                m[2 * q] = bf2f((bf16_t)(a0[q] & 0xffff)) + bf2f((bf16_t)(b0[q] & 0xffff)); m[2 * q + 1] = bf2f((bf16_t)(a0[q] >> 16)) + bf2f((bf16_t)(b0[q] >> 16));
                s[2 * q] = bf2f((bf16_t)(a1[q] & 0xffff)) + bf2f((bf16_t)(b1[q] & 0xffff)); s[2 * q + 1] = bf2f((bf16_t)(a1[q] >> 16)) + bf2f((bf16_t)(b1[q] >> 16));
            }
        }
        float ss = 0.f;
#pragma unroll
        for (int q = 0; q < 8; ++q) ss += m[q] * m[q];
        ss = group16_sum(ss, lane);
        const float rs = rsqf_(ss * (1.f / 128.f) + 1e-6f);
        const u32x4 ov = *(const u32x4*)(Z + (size_t)r * ZLD + 1536 + c0);
        const u32x4 uv = *(const u32x4*)(Z + (size_t)r * ZLD + 2064 + c0);
        unsigned o1[4], o2[4];
#pragma unroll
        for (int q = 0; q < 4; ++q) {
            const float oa = bf2f((bf16_t)(ov[q] & 0xffff)), ob = bf2f((bf16_t)(ov[q] >> 16));
            const float ua = bf2f((bf16_t)(uv[q] & 0xffff)), ub = bf2f((bf16_t)(uv[q] >> 16));
            const float ma = m[2 * q] * rs * mg[c0 + 2 * q] * sigmoidf_(oa), mb = m[2 * q + 1] * rs * mg[c0 + 2 * q + 1] * sigmoidf_(ob);
            const float ya = gelu_tanhf_(s[2 * q] + dsk[c0 + 2 * q] * ua), yb = gelu_tanhf_(s[2 * q + 1] + dsk[c0 + 2 * q + 1] * ub);
            o1[q] = pack2bf(ma, mb); o2[q] = pack2bf(ya, yb);
        }
        *(u32x4*)(CAT + (size_t)r * D + c0) = u32x4{o1[0], o1[1], o1[2], o1[3]};
        *(u32x4*)(YY + (size_t)r * 512 + c0) = u32x4{o2[0], o2[1], o2[2], o2[3]};
    }
}

static __device__ __forceinline__ void phase_post_odd(const Params& P, int j, int bid, int nb, int wv) {
    const int wid = tidx(wv) >> 6, lane = tidx(wv) & 63;
    const bf16_t* MO = (const bf16_t*)(P.ws + WS_MO); const bf16_t* Z = (const bf16_t*)(P.ws + WS_Z); bf16_t* CAT = (bf16_t*)(P.ws + WS_CAT);
    const float* ng = P.in[I_ODNORM] + (size_t)j * D;
    for (int r = bid * 8 + wid; r < NT; r += nb * 8) {
        const int c0 = lane * 16;
        float o[16];
        {
#pragma unroll
            for (int hh = 0; hh < 2; ++hh) {
                const u32x4 a = *(const u32x4*)(MO + (size_t)r * D + c0 + hh * 8), bq = *(const u32x4*)(MO + ((size_t)NT + r) * D + c0 + hh * 8);
#pragma unroll
                for (int q = 0; q < 4; ++q) { o[hh * 8 + 2 * q] = bf2f((bf16_t)(a[q] & 0xffff)) + bf2f((bf16_t)(bq[q] & 0xffff)); o[hh * 8 + 2 * q + 1] = bf2f((bf16_t)(a[q] >> 16)) + bf2f((bf16_t)(bq[q] >> 16)); }
            }
        }
        float ss = 0.f;
#pragma unroll
        for (int q = 0; q < 16; ++q) ss += o[q] * o[q];
        ss = group16_sum(ss, lane);
        const float rs = rsqf_(ss * (1.f / 256.f) + 1e-6f);
#pragma unroll
        for (int hh = 0; hh < 2; ++hh) {
            const u32x4 gv = *(const u32x4*)(Z + (size_t)r * ZLD + 2048 + c0 + hh * 8);
            unsigned w[4];
#pragma unroll
            for (int q = 0; q < 4; ++q) {
                const int c = c0 + hh * 8 + 2 * q;
                const float ga = bf2f((bf16_t)(gv[q] & 0xffff)), gb = bf2f((bf16_t)(gv[q] >> 16));
                w[q] = pack2bf(o[hh * 8 + 2 * q] * rs * ng[c] * siluf_(ga), o[hh * 8 + 2 * q + 1] * rs * ng[c + 1] * siluf_(gb));
            }
            *(u32x4*)(CAT + (size_t)r * D + c0 + hh * 8) = u32x4{w[0], w[1], w[2], w[3]};
        }
    }
}

constexpr int GL_LDQ = 136, GL_LDS = 72, GL_LDB = 129;
constexpr int GL_OFF_Q = 0, GL_OFF_K = GL_OFF_Q + 64 * GL_LDQ * 2, GL_OFF_KD = GL_OFF_K + 64 * GL_LDQ * 2, GL_OFF_VT = GL_OFF_KD + 128 * GL_LDS * 2, GL_OFF_P = GL_OFF_VT + 128 * GL_LDS * 2,
              GL_OFF_ST = GL_OFF_P + 64 * GL_LDS * 2, GL_OFF_B = GL_OFF_ST + 128 * GL_LDQ * 2, GL_OFF_R = GL_OFF_B + 64 * GL_LDB * 4, GL_OFF_TOT = GL_OFF_R + 64 * 16 * 4, GL_LDS_BYTES = GL_OFF_TOT + 4 * 128 * 4;
static __device__ __forceinline__ void phase_gla(char* smem, const Params& P, int j, int bid, int nb, int wv) {
    const int tid = tidx(wv), wid = tid >> 6, lane = tid & 63, fr = lane & 15, fq = lane >> 4;
    bf16_t* sQ = (bf16_t*)(smem + GL_OFF_Q); bf16_t* sK = (bf16_t*)(smem + GL_OFF_K); bf16_t* sKd = (bf16_t*)(smem + GL_OFF_KD); bf16_t* sVt = (bf16_t*)(smem + GL_OFF_VT);
    bf16_t* sP = (bf16_t*)(smem + GL_OFF_P); bf16_t* sSt = (bf16_t*)(smem + GL_OFF_ST); float* sB = (float*)(smem + GL_OFF_B); float* sR = (float*)(smem + GL_OFF_R); float* sTot = (float*)(smem + GL_OFF_TOT);
    const bf16_t* Z = (const bf16_t*)(P.ws + WS_Z); const float* G = (const float*)(P.ws + WS_GATES); bf16_t* MO = (bf16_t*)(P.ws + WS_MO);
    for (int it = bid; it < BATCH * 16; it += nb) {
        const int hf = it & 1, dir = (it >> 1) & 1, head = (it >> 2) & 3, b = it >> 4;
        const float* w2 = P.in[dir ? I_ODW2B : I_ODW2F] + (size_t)j * 16 * 512; const float* b2 = P.in[dir ? I_ODB2B : I_ODB2F] + (size_t)j * 512;
        const int dcol = tid & 127, sg = tid >> 7;
        float w2c[16];
#pragma unroll
        for (int q = 0; q < 16; ++q) w2c[q] = w2[q * 512 + head * 128 + dcol];
        const float b2c = b2[head * 128 + dcol];
        for (int e = tid; e < 128 * GL_LDQ; e += NTHREADS) sSt[e] = 0;
        f32x4 Sacc[8];
#pragma unroll
        for (int n = 0; n < 8; ++n) Sacc[n] = f32x4{0.f, 0.f, 0.f, 0.f};
        __syncthreads();
        for (int ci = 0; ci < NCH; ++ci) {
            if (tid < 256) { const int s = tid >> 2, q4 = tid & 3; const int row = vstep_row(b, dir, ci * 64 + s, true); *(float4*)(sR + s * 16 + q4 * 4) = *(const float4*)(G + (size_t)row * 32 + dir * 16 + q4 * 4); }
            __syncthreads();
            float la[16]; float run = 0.f;
#pragma unroll
            for (int i = 0; i < 16; ++i) {
                const int s = sg * 16 + i; float x = b2c;
#pragma unroll
                for (int q = 0; q < 16; ++q) x += sR[s * 16 + q] * w2c[q];
                run += logsigmoidf_(x) * (1.f / 16.f); la[i] = run;
            }
            sTot[sg * 128 + dcol] = run;
            __syncthreads();
            {
                float pre = 0.f;
#pragma unroll
                for (int q = 0; q < 3; ++q) if (q < sg) pre += sTot[q * 128 + dcol];
#pragma unroll
                for (int i = 0; i < 16; ++i) sB[(sg * 16 + i) * GL_LDB + dcol] = la[i] + pre;
            }
            __syncthreads();
#pragma unroll
            for (int i = 0; i < 2; ++i) {
                const int id = tid + i * 512, s = id >> 4, ch = id & 15; const int row = vstep_row(b, dir, ci * 64 + s, true);
                const u32x4 qv = *(const u32x4*)(Z + (size_t)row * ZLD + head * 128 + ch * 8);
                const u32x4 kv = *(const u32x4*)(Z + (size_t)row * ZLD + 512 + head * 128 + ch * 8);
                const u32x4 vv = *(const u32x4*)(Z + (size_t)row * ZLD + 1024 + head * 256 + hf * 128 + ch * 8);
                unsigned qo[4], ko[4];
#pragma unroll
                for (int q = 0; q < 4; ++q) {
                    const int d0 = ch * 8 + 2 * q;
                    const float bA = sB[s * GL_LDB + d0], bB = sB[s * GL_LDB + d0 + 1], lA = sB[63 * GL_LDB + d0], lB = sB[63 * GL_LDB + d0 + 1];
                    const float qa = bf2f((bf16_t)(qv[q] & 0xffff)) * 0.08838834764831845f, qb = bf2f((bf16_t)(qv[q] >> 16)) * 0.08838834764831845f;
                    const float ka = bf2f((bf16_t)(kv[q] & 0xffff)), kb = bf2f((bf16_t)(kv[q] >> 16));
                    qo[q] = pack2bf(qa * __expf(bA), qb * __expf(bB)); ko[q] = pack2bf(ka * __expf(-bA), kb * __expf(-bB));
                    sKd[d0 * GL_LDS + s] = f2bf(ka * __expf(lA - bA)); sKd[(d0 + 1) * GL_LDS + s] = f2bf(kb * __expf(lB - bB));
                    sVt[d0 * GL_LDS + s] = (bf16_t)(vv[q] & 0xffff); sVt[(d0 + 1) * GL_LDS + s] = (bf16_t)(vv[q] >> 16);
                }
                *(u32x4*)(sQ + s * GL_LDQ + ch * 8) = u32x4{qo[0], qo[1], qo[2], qo[3]};
                *(u32x4*)(sK + s * GL_LDQ + ch * 8) = u32x4{ko[0], ko[1], ko[2], ko[3]};
            }
            __syncthreads();
            {
                const int tt = wid >> 1;
#pragma unroll
                for (int u = 0; u < 2; ++u) {
                    const int st = (wid & 1) * 2 + u;
                    f32x4 acc = f32x4{0.f, 0.f, 0.f, 0.f};
#pragma unroll
                    for (int kk = 0; kk < 4; ++kk) {
                        const bf16x8 a = *(const bf16x8*)(sQ + (tt * 16 + fr) * GL_LDQ + kk * 32 + fq * 8);
                        const bf16x8 bb = *(const bf16x8*)(sK + (st * 16 + fr) * GL_LDQ + kk * 32 + fq * 8);
                        acc = MFMA16(a, bb, acc);
                    }
                    const int s = st * 16 + fr;
#pragma unroll
                    for (int q = 0; q < 4; ++q) { const int t = tt * 16 + fq * 4 + q; sP[t * GL_LDS + s] = f2bf((s <= t) ? acc[q] : 0.f); }
                }
            }
            __syncthreads();
            {
                const int tt = wid & 3;
#pragma unroll
                for (int u = 0; u < 4; ++u) {
                    const int et = (wid >> 2) * 4 + u;
                    f32x4 acc = f32x4{0.f, 0.f, 0.f, 0.f};
#pragma unroll
                    for (int kk = 0; kk < 2; ++kk) {
                        const bf16x8 a = *(const bf16x8*)(sP + (tt * 16 + fr) * GL_LDS + kk * 32 + fq * 8);
                        const bf16x8 bb = *(const bf16x8*)(sVt + (et * 16 + fr) * GL_LDS + kk * 32 + fq * 8);
                        acc = MFMA16(a, bb, acc);
                    }
#pragma unroll
                    for (int kk = 0; kk < 4; ++kk) {
                        const bf16x8 a = *(const bf16x8*)(sQ + (tt * 16 + fr) * GL_LDQ + kk * 32 + fq * 8);
                        const bf16x8 bb = *(const bf16x8*)(sSt + (et * 16 + fr) * GL_LDQ + kk * 32 + fq * 8);
                        acc = MFMA16(a, bb, acc);
                    }
#pragma unroll
                    for (int q = 0; q < 4; ++q) { const int t = tt * 16 + fq * 4 + q; const int row = vstep_row(b, dir, ci * 64 + t, true); MO[((size_t)dir * NT + row) * D + head * 256 + hf * 128 + et * 16 + fr] = f2bf(acc[q]); }
                }
            }
            __syncthreads();
            {
                float dec[4];
#pragma unroll
                for (int q = 0; q < 4; ++q) dec[q] = __expf(sB[63 * GL_LDB + wid * 16 + fq * 4 + q]);
#pragma unroll
                for (int n = 0; n < 8; ++n) {
                    f32x4 c = Sacc[n];
#pragma unroll
                    for (int q = 0; q < 4; ++q) c[q] *= dec[q];
#pragma unroll
                    for (int kk = 0; kk < 2; ++kk) {
                        const bf16x8 a = *(const bf16x8*)(sKd + (wid * 16 + fr) * GL_LDS + kk * 32 + fq * 8);
                        const bf16x8 bb = *(const bf16x8*)(sVt + (n * 16 + fr) * GL_LDS + kk * 32 + fq * 8);
                        c = MFMA16(a, bb, c);
                    }
                    Sacc[n] = c;
                    *(u32x2*)(sSt + (n * 16 + fr) * GL_LDQ + wid * 16 + fq * 4) = u32x2{pack2bf(c[0], c[1]), pack2bf(c[2], c[3])};
                }
            }
            __syncthreads();
        }
    }
}

__device__ __forceinline__ int img256(int r, int c) { return r * 256 + ((c ^ (r & 15)) << 4); }
__device__ __forceinline__ int img128(int r, int c) { return r * 128 + ((c ^ (r & 7)) << 4); }
constexpr int GP_OFF_KT = 73728, GP_OFF_B = GP_OFF_KT + 64 * 136 * 2, GP_OFF_R = GP_OFF_B + 64 * 129 * 4, GP_OFF_TOT = GP_OFF_R + 64 * 16 * 4, GP_LDS_BYTES = GP_OFF_TOT + 4 * 128 * 4;
static __device__ __forceinline__ void phase_gla_prep(char* smem, const Params& P, int j, int bid, int nb, int wv) {
    const int tid = tidx(wv), wid = tid >> 6, lane = tid & 63, fr = lane & 15, fq = lane >> 4;
    bf16_t* sKt = (bf16_t*)(smem + GP_OFF_KT); float* sB = (float*)(smem + GP_OFF_B); float* sR = (float*)(smem + GP_OFF_R); float* sTot = (float*)(smem + GP_OFF_TOT);
    const bf16_t* Z = (const bf16_t*)(P.ws + WS_Z); const float* G = (const float*)(P.ws + WS_GATES);
    const int dcol = tid & 127, sg = tid >> 7;
    const int total = BATCH * 2 * NCH * 4;
    float4 rv = make_float4(0.f, 0.f, 0.f, 0.f); u32x4 qv[2], kv[2], vv[4];
#pragma unroll
    for (int i = 0; i < 2; ++i) { qv[i] = u32x4{0u, 0u, 0u, 0u}; kv[i] = qv[i]; }
#pragma unroll
    for (int i = 0; i < 4; ++i) vv[i] = u32x4{0u, 0u, 0u, 0u};
    auto issue = [&](int itx) {
        const int head = itx & 3, ci = (itx >> 2) % NCH, dir = ((itx >> 2) / NCH) & 1, b = (itx >> 2) / (2 * NCH);
        if (tid < 256) { const int s = tid >> 2, q4 = tid & 3; const int row = vstep_row(b, dir, ci * 64 + s, true); rv = *(const float4*)(G + (size_t)row * 32 + dir * 16 + q4 * 4); }
        const int row = vstep_row(b, dir, ci * 64 + lane, true);
        const bf16_t* zr = Z + (size_t)row * ZLD;
#pragma unroll
        for (int i = 0; i < 2; ++i) { qv[i] = *(const u32x4*)(zr + head * 128 + wid * 16 + i * 8); kv[i] = *(const u32x4*)(zr + 512 + head * 128 + wid * 16 + i * 8); }
#pragma unroll
        for (int i = 0; i < 4; ++i) vv[i] = *(const u32x4*)(zr + 1024 + head * 256 + wid * 32 + i * 8);
    };
    if (bid < total) issue(bid);
    for (int it = bid; it < total; it += nb) {
        const int head = it & 3, dir = ((it >> 2) / NCH) & 1;
        const float* w2 = P.in[dir ? I_ODW2B : I_ODW2F] + (size_t)j * 16 * 512; const float* b2 = P.in[dir ? I_ODB2B : I_ODB2F] + (size_t)j * 512;
        float w2c[16];
#pragma unroll
        for (int q = 0; q < 16; ++q) w2c[q] = w2[q * 512 + head * 128 + dcol];
        const float b2c = b2[head * 128 + dcol];
        const float4 rc = rv; u32x4 qc[2], kc[2], vc[4];
#pragma unroll
        for (int i = 0; i < 2; ++i) { qc[i] = qv[i]; kc[i] = kv[i]; }
#pragma unroll
        for (int i = 0; i < 4; ++i) vc[i] = vv[i];
        if (it + nb < total) issue(it + nb);
        if (tid < 256) { const int s = tid >> 2, q4 = tid & 3; *(float4*)(sR + s * 16 + q4 * 4) = rc; }
        __syncthreads();
        float la[16]; float run = 0.f;
#pragma unroll
        for (int i = 0; i < 16; ++i) {
            const int s = sg * 16 + i; float x = b2c;
#pragma unroll
            for (int q = 0; q < 16; ++q) x += sR[s * 16 + q] * w2c[q];
            run += logsigmoid_fast(x) * (1.f / 16.f); la[i] = run;
        }
        sTot[sg * 128 + dcol] = run;
        __syncthreads();
        {
            float pre = 0.f;
#pragma unroll
            for (int q = 0; q < 3; ++q) if (q < sg) pre += sTot[q * 128 + dcol];
#pragma unroll
            for (int i = 0; i < 16; ++i) sB[(sg * 16 + i) * 129 + dcol] = la[i] + pre;
        }
        __syncthreads();
        {
            const int s = lane;
#pragma unroll
            for (int i = 0; i < 2; ++i) {
                unsigned qo[4], ko[4];
#pragma unroll
                for (int q = 0; q < 4; ++q) {
                    const int d0 = wid * 16 + i * 8 + 2 * q;
                    const float bA = sB[s * 129 + d0], bB = sB[s * 129 + d0 + 1], lA = sB[63 * 129 + d0], lB = sB[63 * 129 + d0 + 1];
                    const float qa = bf2f((bf16_t)(qc[i][q] & 0xffff)) * 0.08838834764831845f, qb = bf2f((bf16_t)(qc[i][q] >> 16)) * 0.08838834764831845f;
                    const float ka = bf2f((bf16_t)(kc[i][q] & 0xffff)), kb = bf2f((bf16_t)(kc[i][q] >> 16));
                    qo[q] = pack2bf(qa * __expf(bA), qb * __expf(bB)); ko[q] = pack2bf(ka * __expf(-bA), kb * __expf(-bB));
                    *(bf16_t*)(smem + GI_KD + img128(d0, s >> 3) + (s & 7) * 2) = f2bf(ka * __expf(lA - bA));
                    *(bf16_t*)(smem + GI_KD + img128(d0 + 1, s >> 3) + (s & 7) * 2) = f2bf(kb * __expf(lB - bB));
                }
                *(u32x4*)(smem + GI_Q + img256(s, wid * 2 + i)) = u32x4{qo[0], qo[1], qo[2], qo[3]};
                *(u32x4*)(sKt + s * 136 + (wid * 2 + i) * 8) = u32x4{ko[0], ko[1], ko[2], ko[3]};
            }
            const int hf = wid >> 2;
#pragma unroll
            for (int i = 0; i < 4; ++i) {
                const int e0 = (wid & 3) * 32 + i * 8;
#pragma unroll
                for (int q = 0; q < 4; ++q) {
                    *(bf16_t*)(smem + GI_VT + hf * 16384 + img128(e0 + 2 * q, s >> 3) + (s & 7) * 2) = (bf16_t)(vc[i][q] & 0xffff);
                    *(bf16_t*)(smem + GI_VT + hf * 16384 + img128(e0 + 2 * q + 1, s >> 3) + (s & 7) * 2) = (bf16_t)(vc[i][q] >> 16);
                }
            }
        }
        __syncthreads();
        {
            const int tt = wid >> 1;
#pragma unroll
            for (int u = 0; u < 2; ++u) {
                const int st = (wid & 1) * 2 + u;
                f32x4 acc = f32x4{0.f, 0.f, 0.f, 0.f};
#pragma unroll
                for (int kk = 0; kk < 4; ++kk) {
                    const bf16x8 a = *(const bf16x8*)(smem + GI_Q + img256(tt * 16 + fr, kk * 4 + fq));
                    const bf16x8 bb = *(const bf16x8*)(sKt + (st * 16 + fr) * 136 + kk * 32 + fq * 8);
                    acc = MFMA16(a, bb, acc);
                }
                const int sidx = st * 16 + fr;
#pragma unroll
                for (int q = 0; q < 4; ++q) { const int t = tt * 16 + fq * 4 + q; *(bf16_t*)(smem + GI_P + img128(t, sidx >> 3) + (sidx & 7) * 2) = f2bf((sidx <= t) ? acc[q] : 0.f); }
            }
        }
        __syncthreads();
        {
            char* dst = P.ws + WS_GIMG + (size_t)it * GI_BYTES;
#pragma unroll
            for (int i = 0; i < 9; ++i) *(u32x4*)(dst + (tid + i * 512) * 16) = *(const u32x4*)(smem + (tid + i * 512) * 16);
            if (tid < 128) ((float*)(dst + GI_DEC))[tid] = __expf(sB[63 * 129 + tid]);
        }
        __syncthreads();
    }
}
constexpr int GS_BUF = 57344, GS_OFF_ST = 2 * GS_BUF, GS_LDS_BYTES = GS_OFF_ST + 32768;
static __device__ __forceinline__ void phase_gla_seq(char* smem, const Params& P, int bid, int nb, int wv) {
    const int tid = tidx(wv), wid = tid >> 6, lane = tid & 63, fr = lane & 15, fq = lane >> 4;
    bf16_t* MO = (bf16_t*)(P.ws + WS_MO);
    for (int it = bid; it < BATCH * 16; it += nb) {
        const int hf = it & 1, dir = (it >> 1) & 1, head = (it >> 2) & 3, b = it >> 4;
        const char* img0 = P.ws + WS_GIMG + ((size_t)((b * 2 + dir) * NCH) * 4 + head) * GI_BYTES;
        auto stage = [&](int ci, int buf) {
            const char* src = img0 + (size_t)ci * 4 * GI_BYTES; char* dstb = smem + buf * GS_BUF;
#pragma unroll
            for (int i = 0; i < 5; ++i) GLDS16(src + (tid + i * 512) * 16, dstb + (tid + i * 512) * 16);
#pragma unroll
            for (int i = 0; i < 2; ++i) GLDS16(src + GI_VT + hf * 16384 + (tid + i * 512) * 16, dstb + 40960 + (tid + i * 512) * 16);
        };
        for (int e = tid; e < 32768 / 4; e += NTHREADS) ((unsigned*)(smem + GS_OFF_ST))[e] = 0u;
        f32x4 Sacc[8];
#pragma unroll
        for (int n = 0; n < 8; ++n) Sacc[n] = f32x4{0.f, 0.f, 0.f, 0.f};
        WAIT_VM0();
        stage(0, 0);
        float4 dec_nx = *(const float4*)(img0 + GI_DEC + (wid * 16 + fq * 4) * 4);
        WAIT_VM0();
        __syncthreads();
        for (int ci = 0; ci < NCH; ++ci) {
            const char* cur = smem + (ci & 1) * GS_BUF;
            const float4 dec4 = dec_nx;
            if (ci + 1 < NCH) { stage(ci + 1, (ci + 1) & 1); dec_nx = *(const float4*)(img0 + (size_t)(ci + 1) * 4 * GI_BYTES + GI_DEC + (wid * 16 + fq * 4) * 4); }
            const int tt = wid & 3;
            f32x4 oacc[4];
            {
                bf16x8 pf[2], qf[4];
#pragma unroll
                for (int kk = 0; kk < 2; ++kk) pf[kk] = *(const bf16x8*)(cur + 32768 + img128(tt * 16 + fr, kk * 4 + fq));
#pragma unroll
                for (int kk = 0; kk < 4; ++kk) qf[kk] = *(const bf16x8*)(cur + img256(tt * 16 + fr, kk * 4 + fq));
#pragma unroll
                for (int u = 0; u < 4; ++u) {
                    const int et = (wid >> 2) * 4 + u;
                    f32x4 acc = f32x4{0.f, 0.f, 0.f, 0.f};
#pragma unroll
                    for (int kk = 0; kk < 2; ++kk) acc = MFMA16(*(const bf16x8*)(cur + 40960 + img128(et * 16 + fr, kk * 4 + fq)), pf[kk], acc);
#pragma unroll
                    for (int kk = 0; kk < 4; ++kk) acc = MFMA16(*(const bf16x8*)(smem + GS_OFF_ST + img256(et * 16 + fr, kk * 4 + fq)), qf[kk], acc);
                    oacc[u] = acc;
                }
            }
            __syncthreads();
            {
                bf16x8 kf[2];
#pragma unroll
                for (int kk = 0; kk < 2; ++kk) kf[kk] = *(const bf16x8*)(cur + 16384 + img128(wid * 16 + fr, kk * 4 + fq));
#pragma unroll
                for (int n = 0; n < 8; ++n) {
                    f32x4 c = Sacc[n]; c[0] *= dec4.x; c[1] *= dec4.y; c[2] *= dec4.z; c[3] *= dec4.w;
#pragma unroll
                    for (int kk = 0; kk < 2; ++kk) c = MFMA16(kf[kk], *(const bf16x8*)(cur + 40960 + img128(n * 16 + fr, kk * 4 + fq)), c);
                    Sacc[n] = c;
                    *(u32x2*)(smem + GS_OFF_ST + img256(n * 16 + fr, wid * 2 + (fq >> 1)) + (fq & 1) * 8) = u32x2{pack2bf(c[0], c[1]), pack2bf(c[2], c[3])};
                }
            }
            WAIT_VM0();
            {
                const int row = vstep_row(b, dir, ci * 64 + tt * 16 + fr, true);
#pragma unroll
                for (int u = 0; u < 4; ++u) {
                    const int et = (wid >> 2) * 4 + u;
                    *(u32x2*)(MO + ((size_t)dir * NT + row) * D + head * 256 + hf * 128 + et * 16 + fq * 4) = u32x2{pack2bf(oacc[u][0], oacc[u][1]), pack2bf(oacc[u][2], oacc[u][3])};
                }
            }
            __syncthreads();
        }
    }
}

constexpr int RT_MAX_TOK = 320;
constexpr int RW_LD = D + 8;
constexpr int RT_LDS_W = 2 * NE * RW_LD * 2;
static_assert(NE == 32, "router is written for 32 experts");
#ifndef RT_COOP_FROM
#define RT_COOP_FROM 8
#endif
static_assert(RT_LDS_W + (2 * NE + 2 * RT_MAX_TOK * 4) * 4 + (64 + 3 * 64 * 8) * 4 <= 155648 - 16, "router LDS");
static __device__ __forceinline__ void phase_norm2_router(char* smem, const Params& P, int layer, int bid, int nb, int wv) {
    const int tid = tidx(wv), wid = tid >> 6, lane = tid & 63, fr = lane & 15, fq = lane >> 4;
    const bf16_t* sWh = (const bf16_t*)smem; const bf16_t* sWl = sWh + NE * RW_LD;
    int* s_cnt = (int*)(smem + RT_LDS_W); int* s_base = s_cnt + NE; int* s_e = s_base + NE; int* s_rank = s_e + RT_MAX_TOK * 4;
    const bool last = (layer == DEPTH - 1);
    const int r_begin = last ? NT_CTX : 0, n_act = NT - r_begin;
    const int per = (n_act + nb - 1) / nb;
    const int r0 = r_begin + bid * per, r1 = (r0 + per < NT) ? r0 + per : NT;
    {
        const bf16_t* src = (const bf16_t*)(P.ws + WS_RWT) + (size_t)layer * 2 * NE * D;
#pragma unroll
        for (int i = 0; i < 2 * NE * D / 8 / NTHREADS; ++i) { const int c = tid + i * NTHREADS, which = c >> 12, row = (c >> 7) & 31, ch = c & 127;
            *(u32x4*)(smem + (which * NE + row) * RW_LD * 2 + ch * 16) = *(const u32x4*)(src + ((size_t)which * NE + row) * D + ch * 8); }
    }
    if (tid < NE) s_cnt[tid] = 0;
    __syncthreads();
    const bf16_t* H = (const bf16_t*)(P.ws + WS_H); bf16_t* A = (bf16_t*)(P.ws + WS_A);
    const float* gffn = P.in[I_NFFNG] + layer * D + fq * 8; const float* rb = P.in[I_RB] + layer * NE;
    const float rb0 = rb[fr], rb1 = rb[16 + fr];
    const int ntok = r1 - r0;
    auto pass1 = [&](const bf16_t* hrow, int k0, int k1) {
        float ss = 0.f;
#pragma unroll 8
        for (int kk = k0; kk < k1; ++kk) { const u32x4 a = *(const u32x4*)(hrow + kk * 32);
#pragma unroll
            for (int q = 0; q < 4; ++q) { const float x0 = bf2f((bf16_t)(a[q] & 0xffff)), x1 = bf2f((bf16_t)(a[q] >> 16)); ss += x0 * x0 + x1 * x1; } }
        return ss;
    };
    auto pass2 = [&](const bf16_t* hrow, int r, bool tok_ok, float rs, int k0, int k1, f32x4& acc0, f32x4& acc1) {
        const float* sh = modv(P, layer, r, 3) + fq * 8; const float* sc = modv(P, layer, r, 4) + fq * 8;
#pragma unroll 4
        for (int kk = k0; kk < k1; ++kk) {
            const u32x4 hv = *(const u32x4*)(hrow + kk * 32); const float4 ga = *(const float4*)(gffn + kk * 32), gb = *(const float4*)(gffn + kk * 32 + 4);
            const float4 ha = make_float4(bf2f((bf16_t)(hv[0] & 0xffff)), bf2f((bf16_t)(hv[0] >> 16)), bf2f((bf16_t)(hv[1] & 0xffff)), bf2f((bf16_t)(hv[1] >> 16)));
            const float4 hb = make_float4(bf2f((bf16_t)(hv[2] & 0xffff)), bf2f((bf16_t)(hv[2] >> 16)), bf2f((bf16_t)(hv[3] & 0xffff)), bf2f((bf16_t)(hv[3] >> 16)));
            const float4 s1a = *(const float4*)(sh + kk * 32), s1b = *(const float4*)(sh + kk * 32 + 4), s2a = *(const float4*)(sc + kk * 32), s2b = *(const float4*)(sc + kk * 32 + 4);
            float f[8];
            f[0] = ha.x * rs * ga.x * (1.f + s2a.x) + s1a.x; f[1] = ha.y * rs * ga.y * (1.f + s2a.y) + s1a.y; f[2] = ha.z * rs * ga.z * (1.f + s2a.z) + s1a.z; f[3] = ha.w * rs * ga.w * (1.f + s2a.w) + s1a.w;
            f[4] = hb.x * rs * gb.x * (1.f + s2b.x) + s1b.x; f[5] = hb.y * rs * gb.y * (1.f + s2b.y) + s1b.y; f[6] = hb.z * rs * gb.z * (1.f + s2b.z) + s1b.z; f[7] = hb.w * rs * gb.w * (1.f + s2b.w) + s1b.w;
            u32x4 ph, pl;
#pragma unroll
            for (int q = 0; q < 4; ++q) {
                ph[q] = pack2bf(f[2 * q], f[2 * q + 1]);
                pl[q] = pack2bf(f[2 * q] - bf2f((bf16_t)(ph[q] & 0xffff)), f[2 * q + 1] - bf2f((bf16_t)(ph[q] >> 16)));
            }
            if (tok_ok) *(u32x2*)((unsigned char*)A + (size_t)r * D + kk * 32 + fq * 8) = u32x2{pack4f8(f[0] * F8_SA, f[1] * F8_SA, f[2] * F8_SA, f[3] * F8_SA), pack4f8(f[4] * F8_SA, f[5] * F8_SA, f[6] * F8_SA, f[7] * F8_SA)};
            const bf16x8 ah = __builtin_bit_cast(bf16x8, ph), al = __builtin_bit_cast(bf16x8, pl);
            const bf16x8 bh0 = *(const bf16x8*)(sWh + fr * RW_LD + kk * 32 + fq * 8), bh1 = *(const bf16x8*)(sWh + (16 + fr) * RW_LD + kk * 32 + fq * 8);
            const bf16x8 bl0 = *(const bf16x8*)(sWl + fr * RW_LD + kk * 32 + fq * 8), bl1 = *(const bf16x8*)(sWl + (16 + fr) * RW_LD + kk * 32 + fq * 8);
            acc0 = MFMA16(ah, bh0, acc0); acc1 = MFMA16(ah, bh1, acc1);
            acc0 = MFMA16(ah, bl0, acc0); acc1 = MFMA16(ah, bl1, acc1);
            acc0 = MFMA16(al, bh0, acc0); acc1 = MFMA16(al, bh1, acc1);
        }
    };
    auto finish = [&](int g, f32x4 acc0, f32x4 acc1) {
#pragma unroll
        for (int q = 0; q < 4; ++q) {
            float c0 = acc0[q] + rb0, c1 = acc1[q] + rb1;
            float tv[4]; int ti[4];
#pragma unroll
            for (int k = 0; k < 4; ++k) {
                float bv = (c1 > c0) ? c1 : c0; int bi = (c1 > c0) ? 16 + fr : fr;
#pragma unroll
                for (int m = 8; m >= 1; m >>= 1) { const float ov = shx(bv, m, lane); const int oi = shx(bi, m, lane); const bool take = (ov > bv) || (ov == bv && oi < bi); bv = take ? ov : bv; bi = take ? oi : bi; }
                tv[k] = bv; ti[k] = bi;
                if (bi == fr) c0 = -3.0e38f;
                if (bi == 16 + fr) c1 = -3.0e38f;
            }
            const int tl = g * 16 + fq * 4 + q;
            if (fr == 0 && r0 + tl < r1) {
                const float e1 = __expf(tv[1] - tv[0]), e2 = __expf(tv[2] - tv[0]), e3 = __expf(tv[3] - tv[0]); const float inv = rcpf_(1.f + e1 + e2 + e3);
                float* tg = (float*)(P.ws + WS_TOKGATE) + (size_t)(r0 + tl) * 4; int* te = (int*)(P.ws + WS_TOKE) + (size_t)(r0 + tl) * 4;
                tg[0] = inv; tg[1] = e1 * inv; tg[2] = e2 * inv; tg[3] = e3 * inv;
#pragma unroll
                for (int k = 0; k < 4; ++k) { te[k] = ti[k]; s_e[tl * 4 + k] = ti[k]; s_rank[tl * 4 + k] = atomicAdd(&s_cnt[ti[k]], 1); }
            }
        }
    };
    if (wid < RT_COOP_FROM && wid * 16 < ntok) {
        const int g = wid;
        const bool tok_ok = r0 + g * 16 + fr < r1;
        const int r = tok_ok ? r0 + g * 16 + fr : r1 - 1;
        const bf16_t* hrow = H + (size_t)r * D + fq * 8;
        float ss = pass1(hrow, 0, 32);
        ss += shx(ss, 16, lane); ss += shx(ss, 32, lane);
        const float rs = rsqf_(ss * (1.f / D) + 1e-6f);
        f32x4 acc0 = f32x4{0.f, 0.f, 0.f, 0.f}, acc1 = acc0;
        pass2(hrow, r, tok_ok, rs, 0, 32, acc0, acc1);
        finish(g, acc0, acc1);
    }
    {
        float* red_ss = (float*)(smem + RT_LDS_W + (2 * NE + 2 * RT_MAX_TOK * 4) * 4);
        float* red_acc = red_ss + 64;
        for (int g = RT_COOP_FROM; g * 16 < ntok; ++g) {
            const bool tok_ok = r0 + g * 16 + fr < r1;
            const int r = tok_ok ? r0 + g * 16 + fr : r1 - 1;
            const bf16_t* hrow = H + (size_t)r * D + fq * 8;
            if (wid < 4) { float ss = pass1(hrow, wid * 8, wid * 8 + 8); ss += shx(ss, 16, lane); ss += shx(ss, 32, lane); if (fq == 0) red_ss[wid * 16 + fr] = ss; }
            __syncthreads();
            f32x4 acc0 = f32x4{0.f, 0.f, 0.f, 0.f}, acc1 = acc0;
            if (wid < 4) {
                const float rs = rsqf_((red_ss[fr] + red_ss[16 + fr] + red_ss[32 + fr] + red_ss[48 + fr]) * (1.f / D) + 1e-6f);
                pass2(hrow, r, tok_ok, rs, wid * 8, wid * 8 + 8, acc0, acc1);
                if (wid > 0) { *(f32x4*)(red_acc + ((wid - 1) * 64 + lane) * 8) = acc0; *(f32x4*)(red_acc + ((wid - 1) * 64 + lane) * 8 + 4) = acc1; }
            }
            __syncthreads();
            if (wid == 0) {
#pragma unroll
                for (int w = 0; w < 3; ++w) { acc0 += *(const f32x4*)(red_acc + (w * 64 + lane) * 8); acc1 += *(const f32x4*)(red_acc + (w * 64 + lane) * 8 + 4); }
                finish(g, acc0, acc1);
            }
            __syncthreads();
        }
    }
    __syncthreads();
    if (tid < NE) s_base[tid] = (int)atomicAdd((unsigned*)(P.ws + WS_CNT) + layer * NE + tid, (unsigned)s_cnt[tid]);
    __syncthreads();
    int* RT = (int*)(P.ws + WS_ROWTOK); int* TP = (int*)(P.ws + WS_TOKPOS);
    for (int q = tid; q < (r1 - r0) * 4; q += NTHREADS) {
        const int tl = q >> 2, r = r0 + tl, e = s_e[q], pos = s_base[e] + s_rank[q];
        RT[(size_t)e * NT + pos] = r; TP[(size_t)r * 4 + (q & 3)] = pos;
    }
}

static __device__ __forceinline__ void phase_moe_gu(char* smem, const Params& P, int layer, int bid, int nb, int wv) {
    int* s_off = (int*)(smem + GEMM2_LDS); int* s_rbe = s_off + 64; const int* s_cnt = s_rbe + MOE_RBE_MAX; unsigned* s_rt = (unsigned*)(smem + GEMM2_LDS + 4096);
    const unsigned* counts = (const unsigned*)(P.ws + WS_CNT) + layer * NE;
    moe_offsets(wv, counts, s_off, s_rbe);
    const int nrb = s_off[NE] / MOE_BM;
    const bf16_t* A = (const bf16_t*)(P.ws + WS_A); const int* RT = (const int*)(P.ws + WS_ROWTOK);
    bf16_t* HDN = (bf16_t*)(P.ws + WS_HDN);
    const int xg = bid & 7, slot = bid >> 3, spx = nb >> 3;
    auto issue_rt = [&](int t, int buf) {
        const int rbg = xg + 8 * (t >> 3);
        if (rbg < nrb && wv < 4) { const int e = uni(s_rbe[rbg]), rb = rbg - s_off[e] / MOE_BM, r = tidx(wv) & 255; GLDS4(RT + (size_t)e * NT + rb * MOE_BM + r, s_rt + buf * 256 + r); }
    };
    issue_rt(slot, 0); WAIT_VM0(); __syncthreads();
    int it = 0;
    for (int t = slot;; t += spx, ++it) {
        const int rbg = xg + 8 * (t >> 3), cb = t & 7;
        if (rbg >= nrb) break;
        const int e = uni(s_rbe[rbg]);
        const int rb = rbg - s_off[e] / MOE_BM, cnt = s_cnt[e];
        const bf16_t* Bt = (const bf16_t*)(P.ws + WS_WGU) + ((size_t)(layer * NE + e) * 2 * D + cb * 256) * (D / 2);
        const float* bgu = P.in[I_BGU] + (size_t)(layer * NE + e) * 2 * D;
        const unsigned* rt = s_rt + (it & 1) * 256;
        gemm_tile256<true>(wv, smem, A, [&](int r) { const unsigned tok = (rb * MOE_BM + r < cnt) ? rt[r] : 0u; return tok * (unsigned)(D / 2); }, Bt, D / 2, D / 2,
                  [&](f32x4 (&acc)[2][2][4][2], int wr, int wc, int fr, int fq) {
#pragma unroll
                      for (int bj = 0; bj < 2; ++bj) {
                          const int jh = (cb * 8 + bj * 4 + wc) * 16 + fq * 4;
                          const float4 b0 = *(const float4*)(bgu + 2 * jh), b1 = *(const float4*)(bgu + 2 * jh + 4);
                          const float bg[4] = {b0.x, b0.z, b1.x, b1.z}, bu[4] = {b0.y, b0.w, b1.y, b1.w};
#pragma unroll
                          for (int ai = 0; ai < 2; ++ai)
#pragma unroll
                              for (int m = 0; m < 4; ++m) {
                                  float hv[4];
#pragma unroll
                                  for (int q = 0; q < 4; ++q) {
                                      const float g = fminf(acc[ai][bj][m][0][q] * (1.f / (F8_SA * F8_SW)) + bg[q], 7.f), u = fminf(fmaxf(acc[ai][bj][m][1][q] * (1.f / (F8_SA * F8_SW)) + bu[q], -7.f), 7.f);
                                      hv[q] = (u + 1.f) * (g * sigmoidf_(1.702f * g));
                                  }
                                  *(unsigned*)((unsigned char*)HDN + (size_t)(rbg * MOE_BM + ai * 128 + wr * 64 + m * 16 + fr) * D + jh) = pack4f8(hv[0] * F8_SH, hv[1] * F8_SH, hv[2] * F8_SH, hv[3] * F8_SH);
                              }
                      }
                  },
                  [&]() { issue_rt(t + spx, (it + 1) & 1); });
    }
}
static __device__ __forceinline__ void phase_moe_down(char* smem, const Params& P, int layer, int bid, int nb, int wv) {
    int* s_off = (int*)(smem + GEMM2_LDS);
    const unsigned* counts = (const unsigned*)(P.ws + WS_CNT) + layer * NE;
    int* s_rbe = s_off + 64;
    moe_offsets(wv, counts, s_off, s_rbe);
    const int nrb = s_off[NE] / MOE_BM;
    const bf16_t* HDN = (const bf16_t*)(P.ws + WS_HDN); bf16_t* YB = (bf16_t*)(P.ws + WS_YB);
    const int xg = bid & 7, slot = bid >> 3, spx = nb >> 3;
    for (int t = slot;; t += spx) {
        const int rbg = xg + 8 * (t >> 2), cb = t & 3;
        if (rbg >= nrb) break;
        const int e = uni(s_rbe[rbg]);
        const bf16_t* Bt = (const bf16_t*)(P.ws + WS_WDN) + ((size_t)(layer * NE + e) * D + cb * 256) * (D / 2);
        const float* bd = P.in[I_BDN] + (size_t)(layer * NE + e) * D + cb * 256;
        gemm_tile256<true>(wv, smem, HDN, [&](int r) { return (unsigned)(rbg * MOE_BM + r) * (unsigned)(D / 2); }, Bt, D / 2, D / 2,
                  [&](f32x4 (&acc)[2][2][4][2], int wr, int wc, int fr, int fq) {
                      epi256_vec4(acc, wr, wc, fr, fq, [&](int r, int c, f32x4 v) { const float4 bb = *(const float4*)(bd + c); const float sc = F8_SY / (F8_SH * F8_SW); *(unsigned*)((unsigned char*)YB + (size_t)(rbg * MOE_BM + r) * D + cb * 256 + c) = pack4f8(v[0] * sc + bb.x * F8_SY, v[1] * sc + bb.y * F8_SY, v[2] * sc + bb.z * F8_SY, v[3] * sc + bb.w * F8_SY); });
                  });
    }
}

static __device__ __forceinline__ void phase_final(char* smem, const Params& P, int bid, int nb, int wv) {
    int* s_off = (int*)smem;
    moe_offsets(wv, (const unsigned*)(P.ws + WS_CNT) + (DEPTH - 1) * NE, s_off);
    const int wid = tidx(wv) >> 6, lane = tidx(wv) & 63;
    const bf16_t* H = (const bf16_t*)(P.ws + WS_H); const bf16_t* YB = (const bf16_t*)(P.ws + WS_YB); const float* fg = P.in[I_FNORM];
    for (int r = NT_CTX + bid * 8 + wid; r < NT; r += nb * 8) {
        float v[16], mo[16];
#pragma unroll
        for (int i = 0; i < 4; ++i) { const u32x2 t = *(const u32x2*)(H + (size_t)r * D + 256 * i + 4 * lane); v[4 * i] = bf2f((bf16_t)(t[0] & 0xffff)); v[4 * i + 1] = bf2f((bf16_t)(t[0] >> 16)); v[4 * i + 2] = bf2f((bf16_t)(t[1] & 0xffff)); v[4 * i + 3] = bf2f((bf16_t)(t[1] >> 16)); }
        const int* te = (const int*)(P.ws + WS_TOKE) + r * 4; const int* tp = (const int*)(P.ws + WS_TOKPOS) + r * 4; const float* tg = (const float*)(P.ws + WS_TOKGATE) + r * 4;
        const float* g2 = modv(P, DEPTH - 1, r, 5);
#pragma unroll
        for (int i = 0; i < 16; ++i) mo[i] = 0.f;
#pragma unroll
        for (int k = 0; k < 4; ++k) {
            const size_t row = (size_t)(s_off[te[k]] + tp[k]); const float g = tg[k] * (1.f / F8_SY);
#pragma unroll
            for (int i = 0; i < 4; ++i) { float y[4]; unpack4f8(*(const unsigned*)((const unsigned char*)YB + row * D + 256 * i + 4 * lane), y);
                mo[4 * i] += g * y[0]; mo[4 * i + 1] += g * y[1]; mo[4 * i + 2] += g * y[2]; mo[4 * i + 3] += g * y[3]; }
        }
#pragma unroll
        for (int i = 0; i < 4; ++i) { const float4 t = *(const float4*)(g2 + 256 * i + 4 * lane); v[4 * i] += t.x * mo[4 * i]; v[4 * i + 1] += t.y * mo[4 * i + 1]; v[4 * i + 2] += t.z * mo[4 * i + 2]; v[4 * i + 3] += t.w * mo[4 * i + 3]; }
        float ss = 0.f;
#pragma unroll
        for (int i = 0; i < 16; ++i) ss += v[i] * v[i];
        ss = wave_sum(ss, lane);
        const float rs = rsqf_(ss * (1.f / D) + 1e-6f);
#pragma unroll
        for (int i = 0; i < 4; ++i) { const int c = 256 * i + 4 * lane; const float4 g = *(const float4*)(fg + c);
            *(float4*)(P.out + (size_t)(r - NT_CTX) * D + c) = make_float4(v[4 * i] * rs * g.x, v[4 * i + 1] * rs * g.y, v[4 * i + 2] * rs * g.z, v[4 * i + 3] * rs * g.w); }
    }
}

static __device__ __forceinline__ void phase_inproj_even(char* smem, const Params& P, int j, int bid, int nb, int wv) {
    bf16_t* Z = (bf16_t*)(P.ws + WS_Z); float* G = (float*)(P.ws + WS_GATES); const float* bin = P.in[I_EVBIN] + (size_t)j * P_EVEN;
    phase_gemm_dense(smem, (const bf16_t*)(P.ws + WS_A), D, (const bf16_t*)(P.ws + WS_WEVIN) + (size_t)j * P_EVEN_PAD * D, D, NT, P_EVEN_PAD, bid, nb, wv,
        [&](f32x4 (&acc)[2][2][4][2], int wr, int wc, int fr, int fq, int row0, int col0) {
            epi256_vec4(acc, wr, wc, fr, fq, [&](int r, int c, f32x4 v) {
                const int col = col0 + c, row = row0 + r;
                if (col < P_EVEN) {
                    const float4 bb = *(const float4*)(bin + col); v[0] += bb.x; v[1] += bb.y; v[2] += bb.z; v[3] += bb.w;
                    if (col >= 2048 && col < 2064) *(float4*)(G + (size_t)row * 32 + col - 2048) = make_float4(v[0], v[1], v[2], v[3]);
                    else *(u32x2*)(Z + (size_t)row * ZLD + col) = u32x2{pack2bf(v[0], v[1]), pack2bf(v[2], v[3])};
                }
            });
        });
}
static __device__ __forceinline__ void phase_inproj_odd(char* smem, const Params& P, int j, int bid, int nb, int wv) {
    bf16_t* Z = (bf16_t*)(P.ws + WS_Z); float* G = (float*)(P.ws + WS_GATES);
    phase_gemm_dense(smem, (const bf16_t*)(P.ws + WS_A), D, (const bf16_t*)(P.ws + WS_WODIN) + (size_t)j * P_ODD_PAD * D, D, NT, P_ODD_PAD, bid, nb, wv,
        [&](f32x4 (&acc)[2][2][4][2], int wr, int wc, int fr, int fq, int row0, int col0) {
            epi256_vec4(acc, wr, wc, fr, fq, [&](int r, int c, f32x4 v) {
                const int col = col0 + c, row = row0 + r;
                if (col < 3072) *(u32x2*)(Z + (size_t)row * ZLD + col) = u32x2{pack2bf(v[0], v[1]), pack2bf(v[2], v[3])};
                else if (col < P_ODD) *(float4*)(G + (size_t)row * 32 + col - 3072) = make_float4(v[0], v[1], v[2], v[3]);
            });
        });
}
static __device__ __forceinline__ void phase_glu(char* smem, const Params& P, int j, int bid, int nb, int wv) {
    const bf16_t* YY = (const bf16_t*)(P.ws + WS_YY); bf16_t* CAT = (bf16_t*)(P.ws + WS_CAT); const float* gb = P.in[I_GLUB] + (size_t)j * 512;
    phase_gemm_dense(smem, YY, 512, (const bf16_t*)(P.ws + WS_WGLU) + (size_t)j * 512 * 512, 512, NT, 512, bid, nb, wv,
        [&](f32x4 (&acc)[2][2][4][2], int wr, int wc, int fr, int fq, int row0, int col0) {
            epi256_vec4(acc, wr, wc, fr, fq, [&](int r, int c, f32x4 v) {
                const int col = col0 + c, row = row0 + r; const u32x2 yv = *(const u32x2*)(YY + (size_t)row * 512 + col); const float4 bb = *(const float4*)(gb + col);
                const float y0 = bf2f((bf16_t)(yv[0] & 0xffff)), y1 = bf2f((bf16_t)(yv[0] >> 16)), y2 = bf2f((bf16_t)(yv[1] & 0xffff)), y3 = bf2f((bf16_t)(yv[1] >> 16));
                *(u32x2*)(CAT + (size_t)row * D + 512 + col) = u32x2{pack2bf(y0 * sigmoidf_(v[0] + bb.x), y1 * sigmoidf_(v[1] + bb.y)), pack2bf(y2 * sigmoidf_(v[2] + bb.z), y3 * sigmoidf_(v[3] + bb.w))};
            });
        });
}
static __device__ __forceinline__ void phase_outproj(char* smem, const Params& P, int layer, const bf16_t* Wt, int bid, int nb, int wv) {
    bf16_t* H = (bf16_t*)(P.ws + WS_H);
    phase_gemm_dense(smem, (const bf16_t*)(P.ws + WS_CAT), D, Wt, D, NT, D, bid, nb, wv,
        [&](f32x4 (&acc)[2][2][4][2], int wr, int wc, int fr, int fq, int row0, int col0) {
            epi256_vec4(acc, wr, wc, fr, fq, [&](int r, int c, f32x4 v) {
                const int col = col0 + c, row = row0 + r; const float4 g = *(const float4*)(modv(P, layer, row, 2) + col);
                u32x2* hp = (u32x2*)(H + (size_t)row * D + col); const u32x2 h = *hp;
                *hp = u32x2{pack2bf(bf2f((bf16_t)(h[0] & 0xffff)) + g.x * v[0], bf2f((bf16_t)(h[0] >> 16)) + g.y * v[1]), pack2bf(bf2f((bf16_t)(h[1] & 0xffff)) + g.z * v[2], bf2f((bf16_t)(h[1] >> 16)) + g.w * v[3])};
            });
        });
}

constexpr int LDS_BYTES = 155648;
static_assert(GP_LDS_BYTES <= LDS_BYTES - 16 && GS_LDS_BYTES <= LDS_BYTES - 16 && GL_LDS_BYTES <= LDS_BYTES && S5_LDS_BYTES <= LDS_BYTES && ML_LDS_BYTES <= LDS_BYTES && GEMM_LDS + 256 <= LDS_BYTES && GEMM2_LDS + 256 <= LDS_BYTES, "LDS budget");
static_assert((BATCH + 1) * D * 4 + 8 * (BATCH + 1) * 64 * 4 <= LDS_BYTES, "modvec LDS");

#define KDEF(name, body) __global__ void __launch_bounds__(NTHREADS, 2) name(Params P, int a0, int a1) { SMEM_DECL; (void)a0; (void)a1; const int bid = blockIdx.x, nb = gridDim.x, wv = (int)(threadIdx.x >> 6); body; }
#if !MULTI_LAUNCH
KDEF(k_s5, phase_s5(smem, P, a0, bid, nb, wv))
#endif
#if MULTI_LAUNCH
#define KDEF_UNUSED(name, body) __global__ void __launch_bounds__(NTHREADS, 2) name(Params P, int a0, int a1) { SMEM_DECL; (void)a0; (void)a1; const int bid = blockIdx.x, nb = gridDim.x, wv = (int)(threadIdx.x >> 6); body; }
KDEF(k_prologue, phase_prologue(smem, P, bid, nb, wv))
KDEF(k_norm1, phase_norm1(smem, P, a0, bid, nb, wv))
KDEF(k_inproj_even, phase_inproj_even(smem, P, a0, bid, nb, wv))
KDEF(k_inproj_odd, phase_inproj_odd(smem, P, a0, bid, nb, wv))
KDEF(k_conv, phase_conv(P, a0, bid, nb, wv))
KDEF(k_mlstm, phase_mlstm(smem, P, bid, nb, wv))
KDEF(k_s5, phase_s5(smem, P, a0, bid, nb, wv))
KDEF(k_post_even, phase_post_even(P, a0, bid, nb, wv))
KDEF(k_glu, phase_glu(smem, P, a0, bid, nb, wv))
KDEF(k_outproj_even, phase_outproj(smem, P, a0, (const bf16_t*)(P.ws + WS_WEVOUT) + (size_t)a1 * D * D, bid, nb, wv))
KDEF(k_outproj_odd, phase_outproj(smem, P, a0, (const bf16_t*)(P.ws + WS_WODOUT) + (size_t)a1 * D * D, bid, nb, wv))
KDEF(k_gla_prep, phase_gla_prep(smem, P, a0, bid, nb, wv))
KDEF(k_gla_seq, phase_gla_seq(smem, P, bid, nb, wv))
KDEF(k_post_odd, phase_post_odd(P, a0, bid, nb, wv))
KDEF(k_norm2_router, phase_norm2_router(smem, P, a0, bid, nb, wv))
KDEF(k_moe_gu, phase_moe_gu(smem, P, a0, bid, nb, wv))
KDEF(k_moe_down, phase_moe_down(smem, P, a0, bid, nb, wv))
KDEF(k_final, phase_final(smem, P, bid, nb, wv))
#endif


#if !MULTI_LAUNCH
#define XB_TMO      128
#define XB_XCNT(j)  (256  + 64 * (j))
#define XB_XSUB(j)  (1280 + 64 * (j))
#define XB_XGEN(j)  (2304 + 64 * (j))
#define XB_TOP      3328
#define XB_TOPGEN   3392
#define XCD_BAR_WORDS 3456
#define XB_SPIN_CAP (1u << 18)
#define LAS __attribute__((address_space(3)))
static_assert(XCD_BAR_WORDS == XCD_BAR_WORDS_C, "barrier words");
__device__ __forceinline__ unsigned xb_ld(unsigned* p)              { return __hip_atomic_load(p, __ATOMIC_RELAXED, __HIP_MEMORY_SCOPE_AGENT); }
__device__ __forceinline__ unsigned xb_add(unsigned* p, unsigned v) { return __hip_atomic_fetch_add(p, v, __ATOMIC_RELAXED, __HIP_MEMORY_SCOPE_AGENT); }
__device__ __forceinline__ unsigned xb_xcc_id() { return (unsigned)__builtin_amdgcn_s_getreg((3 << 11) | 20) & 0xFu; }
#define XB_SPIN(cond, bar) do { unsigned _sp = 0; while (cond) { __builtin_amdgcn_s_sleep(1); \
    if ((++_sp & 255u) == 0u) { if (xb_ld(&(bar)[XB_TMO])) break; if (_sp > XB_SPIN_CAP) { atomicAdd(&(bar)[XB_TMO], 1u); break; } } } } while (0)
struct XcdBarrier { unsigned* bar; unsigned x; volatile LAS unsigned* st; };
__device__ __forceinline__ XcdBarrier xcd_barrier_post(unsigned* bar, volatile LAS unsigned* st) {
    XcdBarrier b; b.bar = bar; b.x = xb_xcc_id(); b.st = st;
    if (threadIdx.x == 0) (void)xb_add(&bar[XB_XCNT(b.x)], 1u);
    return b;
}
__device__ __forceinline__ void xcd_barrier_complete(unsigned* bar, unsigned x, unsigned& nloc, unsigned& nx) {
    const unsigned G = gridDim.x * gridDim.y * gridDim.z;
    unsigned sum, cnt, mine, sp = 0u;
    for (;;) {
        sum = 0u; cnt = 0u; mine = 0u;
#pragma unroll
        for (unsigned j = 0; j < 16; ++j) { const unsigned c = xb_ld(&bar[XB_XCNT(j)]); sum += c; cnt += (c > 0u) ? 1u : 0u; }
        if (sum == G) { mine = xb_ld(&bar[XB_XCNT(x)]); break; }
        __builtin_amdgcn_s_sleep(1);
        if ((++sp & 255u) == 0u) { if (xb_ld(&bar[XB_TMO])) break; if (sp > XB_SPIN_CAP) { atomicAdd(&bar[XB_TMO], 1u); break; } }
    }
    nloc = mine > 0u ? mine : 1u; nx = cnt > 0u ? cnt : 1u;
}
__device__ __forceinline__ void xcd_barrier(const XcdBarrier& b) {
    asm volatile("s_waitcnt vmcnt(0)" ::: "memory");
    __syncthreads();
    if (threadIdx.x == 0) {
        unsigned* bar = b.bar;
        __builtin_amdgcn_s_waitcnt(0);
        unsigned nloc = b.st[0], nx = b.st[1];
        if (nloc == 0u) { xcd_barrier_complete(bar, b.x, nloc, nx); b.st[0] = nloc; b.st[1] = nx; }
        const unsigned old = xb_add(&bar[XB_XSUB(b.x)], 1u);
        const unsigned gen = old / nloc;
        if (old + 1u == (gen + 1u) * nloc) {
            __builtin_amdgcn_fence(__ATOMIC_RELEASE, "agent");
            asm volatile("s_waitcnt vmcnt(0)" ::: "memory");
            const unsigned og = xb_add(&bar[XB_TOP], 1u);
            const unsigned tg = og / nx;
            if (og + 1u == (tg + 1u) * nx) xb_add(&bar[XB_TOPGEN], 1u);
            else XB_SPIN(xb_ld(&bar[XB_TOPGEN]) == tg, bar);
            __builtin_amdgcn_fence(__ATOMIC_ACQUIRE, "agent");
            xb_add(&bar[XB_XGEN(b.x)], 1u);
            asm volatile("s_waitcnt vmcnt(0)" ::: "memory");
        } else {
            XB_SPIN(xb_ld(&bar[XB_XGEN(b.x)]) == gen, bar);
            __builtin_amdgcn_fence(__ATOMIC_ACQUIRE, "agent");
            asm volatile("s_waitcnt vmcnt(0)" ::: "memory");
        }
    }
    __syncthreads();
}

__device__ __forceinline__ Params load_params() {
#if defined(__HIP_DEVICE_COMPILE__)
    const __attribute__((address_space(4))) Params* kp = (const __attribute__((address_space(4))) Params*)__builtin_amdgcn_kernarg_segment_ptr();
    asm volatile("" : "+s"(kp));
    Params r;
#pragma unroll
    for (int i = 0; i < N_INPUTS; ++i) r.in[i] = kp->in[i];
    r.out = kp->out; r.ws = kp->ws;
    return r;
#else
    return Params{};
#endif
}
__global__ void __launch_bounds__(NTHREADS, 2) k_mega(Params P, int ph_begin, int ph_end, int bar_slot) {
    SMEM_DECL;
    volatile LAS unsigned* st = (volatile LAS unsigned*)(smem + LDS_BYTES - 16);
    if (threadIdx.x == 0) { st[0] = 0u; st[1] = 0u; st[2] = 0u; st[3] = 0u; }
    __syncthreads();
    const XcdBarrier bar = xcd_barrier_post((unsigned*)(P.ws + WS_BAR) + (size_t)bar_slot * XCD_BAR_WORDS, st);
    const int nb = gridDim.x;
    const int wv = __builtin_amdgcn_readfirstlane((int)(threadIdx.x >> 6));
    int pc = 0;
#define PH(call) do { if (pc >= ph_begin && pc < ph_end) { const Params P = load_params(); int bid = blockIdx.x; asm volatile("" : "+s"(bid)); call; if (pc + 1 < ph_end) xcd_barrier(bar); } ++pc; } while (0)
#ifndef TIMING_DUP
#define TIMING_DUP 0
#endif
#define PHD(bit, call) do { PH(call); if ((TIMING_DUP >> (bit)) & 1) { PH(call); } } while (0)
    PHD(0, phase_prologue(smem, P, bid, nb, wv));
#pragma unroll 1
    for (int layer = 0; layer < DEPTH; ++layer) {
        const int j = layer >> 1;
        PH(phase_norm1(smem, P, layer, bid, nb, wv));
        if ((layer & 1) == 0) {
            PHD(1, phase_inproj_even(smem, P, j, bid, nb, wv));
            PHD(2, phase_conv(P, j, bid, nb, wv));
            PHD(3, (bid < (nb >> 1)) ? phase_mlstm(smem, P, bid, nb >> 1, wv) : phase_s5(smem, P, j, bid - (nb >> 1), nb - (nb >> 1), wv));
            PHD(5, phase_post_even(P, j, bid, nb, wv));
            PHD(6, phase_glu(smem, P, j, bid, nb, wv));
        } else {
            PHD(1, phase_inproj_odd(smem, P, j, bid, nb, wv));
            PHD(7, phase_gla_prep(smem, P, j, bid, nb, wv));
            PHD(13, phase_gla_seq(smem, P, bid, nb, wv));
            PHD(5, phase_post_odd(P, j, bid, nb, wv));
        }
        PH(phase_outproj(smem, P, layer, (const bf16_t*)(P.ws + ((layer & 1) ? WS_WODOUT : WS_WEVOUT)) + (size_t)j * D * D, bid, nb, wv));
        PH(phase_norm2_router(smem, P, layer, bid, nb, wv));
        PHD(8, phase_moe_gu(smem, P, layer, bid, nb, wv));
        PHD(9, phase_moe_down(smem, P, layer, bid, nb, wv));
    }
    PH(phase_final(smem, P, bid, nb, wv));
}
#endif

#ifdef HOST_EMU
#ifndef EMU_GRID
#define EMU_GRID 16
#endif
static const int kGrid = EMU_GRID;
int g_stop_after = 1000;
void emu_hook(int step, const char* name, const Params& p);
#define RUN(k, a0, a1) do { if (step < g_stop_after) { LAUNCH(k, kGrid, NTHREADS, LDS_BYTES, stream, p, a0, a1); emu_hook(step, #k, p); } ++step; } while (0)
#else
static const int kGrid = 256;
#define RUN(k, a0, a1) do { ++step; LAUNCH(k, kGrid, NTHREADS, LDS_BYTES, stream, p, a0, a1); } while (0)
#endif

extern "C" void kernel_launch(void* const* d_in, const int* in_sizes, int n_in, void* d_out, int out_size, void* d_ws, size_t ws_size, hipStream_t stream) {
    (void)in_sizes; (void)n_in; (void)out_size;
    if (ws_size < WS_TOTAL) { fprintf(stderr, "kernel_launch: workspace too small (%zu < %zu)\n", ws_size, (size_t)WS_TOTAL); return; }
    Params p{};
    for (int i = 0; i < N_INPUTS; ++i) p.in[i] = (const float*)d_in[i];
    p.out = (float*)d_out; p.ws = (char*)d_ws;
    (void)hipMemsetAsync(d_ws, 0, WS_ZERO_BYTES, stream);
    int step = 0;
#if MULTI_LAUNCH
#ifndef HOST_EMU
    static bool attr_done = false;
    if (!attr_done) {
        attr_done = true;
        const void* ks[] = {(const void*)k_prologue, (const void*)k_norm1, (const void*)k_inproj_even, (const void*)k_inproj_odd, (const void*)k_conv, (const void*)k_mlstm, (const void*)k_s5,
                            (const void*)k_post_even, (const void*)k_glu, (const void*)k_outproj_even, (const void*)k_outproj_odd, (const void*)k_gla_prep, (const void*)k_gla_seq, (const void*)k_post_odd,
                            (const void*)k_norm2_router, (const void*)k_moe_gu, (const void*)k_moe_down, (const void*)k_final};
        for (const void* k : ks) if (hipFuncSetAttribute(k, hipFuncAttributeMaxDynamicSharedMemorySize, LDS_BYTES) != hipSuccess) fprintf(stderr, "kernel_launch: hipFuncSetAttribute failed\n");
    }
#endif
    RUN(k_prologue, 0, 0);
    for (int layer = 0; layer < DEPTH; ++layer) {
        const int j = layer / 2;
        RUN(k_norm1, layer, 0);
        if ((layer & 1) == 0) {
            RUN(k_inproj_even, j, 0);
            RUN(k_conv, j, 0);
            RUN(k_mlstm, 0, 0);
            RUN(k_s5, j, 0);
            RUN(k_post_even, j, 0);
            RUN(k_glu, j, 0);
            RUN(k_outproj_even, layer, j);
        } else {
            RUN(k_inproj_odd, j, 0);
            RUN(k_gla_prep, j, 0);
            RUN(k_gla_seq, 0, 0);
            RUN(k_post_odd, j, 0);
            RUN(k_outproj_odd, layer, j);
        }
        RUN(k_norm2_router, layer, 0);
        RUN(k_moe_gu, layer, 0);
        RUN(k_moe_down, layer, 0);
    }
    RUN(k_final, 0, 0);
#else
    static int grid = 0;
    if (!grid) {
        int dev = 0, cus = 0, per_cu = 0;
        (void)hipGetDevice(&dev);
        (void)hipDeviceGetAttribute(&cus, hipDeviceAttributeMultiprocessorCount, dev);
        if (hipFuncSetAttribute((const void*)k_mega, hipFuncAttributeMaxDynamicSharedMemorySize, LDS_BYTES) != hipSuccess) fprintf(stderr, "kernel_launch: hipFuncSetAttribute failed\n");
        if (hipOccupancyMaxActiveBlocksPerMultiprocessor(&per_cu, (const void*)k_mega, NTHREADS, LDS_BYTES) != hipSuccess || per_cu < 1) fprintf(stderr, "kernel_launch: occupancy query says %d blocks per CU\n", per_cu);
        grid = cus > 0 ? cus : 256;
    }
    (void)step;
    hipLaunchKernelGGL(k_mega, dim3(grid), dim3(NTHREADS), LDS_BYTES, stream, p, 0, 1000, 0);

#endif
}
```
